# Optimizing an MI355X kernel written in HIP

```python
import jax, jax.numpy as jnp
from jax import lax
import numpy as np

D_MODEL = 1024
BATCH = 8
SEQ = 4096
DEPTH = 2

HEAD_DIM = 64
N_HEADS_A = 12
N_KV_A = 4
IDX_HEADS = 8
IDX_DIM = 64
IDX_ROPE_DIM = 32
TOPK_MAX = 256
DIL_PATTERNS = ((128, 1), (512, 4), (2048, 16))
HEADS_PER_DIL = 4
N_MEM_HEADS = 4
MEM_TOKENS = 256
D_FF = ((8 * D_MODEL // 3 + 255) // 256) * 256
BLK = 128
ROPE_THETA = 10000.0
EPS = 1e-6
NEG = -1e30

A_SIZES = (N_HEADS_A * HEAD_DIM, N_KV_A * HEAD_DIM, N_KV_A * HEAD_DIM,
           IDX_HEADS * IDX_DIM, IDX_DIM, IDX_HEADS, N_MEM_HEADS * HEAD_DIM)
A_IN = sum(A_SIZES)
A_OUT = (N_HEADS_A + N_MEM_HEADS) * HEAD_DIM
B_SIZES = (HEADS_PER_DIL * HEAD_DIM,) * (3 * len(DIL_PATTERNS)) + (N_MEM_HEADS * HEAD_DIM,)
B_IN = sum(B_SIZES)
B_OUT = (HEADS_PER_DIL + N_MEM_HEADS) * HEAD_DIM

kernel_name = 'hybrid_dsa_dilated_decoder'


def _split(t, sizes):
    offs = np.cumsum(sizes)[:-1].tolist()
    return jnp.split(t, offs, axis=-1)


def rms_norm(x, g):
    xf = x.astype(jnp.float32)
    y = xf * lax.rsqrt(jnp.mean(xf * xf, axis=-1, keepdims=True) + EPS)
    return (y * g.astype(jnp.float32)).astype(x.dtype)


def rope(x, pos, rot_dim):
    half = rot_dim // 2
    freqs = ROPE_THETA ** (-jnp.arange(half, dtype=jnp.float32) / half)
    ang = pos.astype(jnp.float32)[:, :, None, None] * freqs
    cos, sin = jnp.cos(ang), jnp.sin(ang)
    xr = x[..., :rot_dim].astype(jnp.float32)
    x1, x2 = xr[..., :half], xr[..., half:]
    rot = jnp.concatenate([x1 * cos - x2 * sin, x2 * cos + x1 * sin], axis=-1).astype(x.dtype)
    return jnp.concatenate([rot, x[..., rot_dim:]], axis=-1)


def dsa_mixer(proj, pos):
    bsz, seq, _ = proj.shape
    q, k, v, qi, ki, wi, qm = _split(proj, A_SIZES)
    q = rope(q.reshape(bsz, seq, N_HEADS_A, HEAD_DIM), pos, HEAD_DIM)
    k = rope(k.reshape(bsz, seq, N_KV_A, HEAD_DIM), pos, HEAD_DIM)
    v = v.reshape(bsz, seq, N_KV_A, HEAD_DIM)
    qi = rope(qi.reshape(bsz, seq, IDX_HEADS, IDX_DIM), pos, IDX_ROPE_DIM)
    ki = rope(ki.reshape(bsz, seq, 1, IDX_DIM), pos, IDX_ROPE_DIM)[:, :, 0]
    wi = wi.astype(jnp.float32) * (IDX_HEADS ** -0.5 * IDX_DIM ** -0.5)
    n_sel = min(TOPK_MAX, seq // 4)
    grp = N_HEADS_A // N_KV_A
    scale = HEAD_DIM ** -0.5
    key_pos = jnp.arange(seq)
    b_idx = jnp.arange(bsz)[:, None, None]

    def block(i):
        start = i * BLK
        qb = lax.dynamic_slice_in_dim(q, start, BLK, axis=1)
        qib = lax.dynamic_slice_in_dim(qi, start, BLK, axis=1)
        wib = lax.dynamic_slice_in_dim(wi, start, BLK, axis=1)
        t_pos = start + jnp.arange(BLK)
        logits = jnp.einsum('bqhd,bsd->bqhs', qib, ki, preferred_element_type=jnp.float32)
        score = jnp.einsum('bqhs,bqh->bqs', jax.nn.relu(logits), wib)
        score = jnp.where(key_pos[None, None, :] <= t_pos[None, :, None], score, NEG)
        _, idx = lax.top_k(score, n_sel)
        k_sel = k[b_idx, idx]
        v_sel = v[b_idx, idx]
        qg = qb.reshape(bsz, BLK, N_KV_A, grp, HEAD_DIM)
        s = jnp.einsum('bqkgd,bqskd->bqkgs', qg, k_sel, preferred_element_type=jnp.float32) * scale
        valid = (idx <= t_pos[None, :, None])[:, :, None, None, :]
        p = jax.nn.softmax(jnp.where(valid, s, NEG), axis=-1)
        o = jnp.einsum('bqkgs,bqskd->bqkgd', p, v_sel.astype(jnp.float32))
        return o.reshape(bsz, BLK, N_HEADS_A * HEAD_DIM).astype(proj.dtype)

    out = lax.map(block, jnp.arange(seq // BLK))
    out = out.transpose(1, 0, 2, 3).reshape(bsz, seq, N_HEADS_A * HEAD_DIM)
    return out, qm


def dilated_group(q, k, v, window, dil):
    bsz, seq, nh, hd = q.shape
    steps = window // dil
    n = seq // dil
    nb = -(-n // BLK)
    n_pad = nb * BLK

    def to_sub(t, front):
        t = t.reshape(bsz, n, dil, nh, hd).transpose(0, 2, 3, 1, 4)
        return jnp.pad(t, ((0, 0), (0, 0), (0, 0), (front, n_pad - n), (0, 0)))

    qs = to_sub(q, 0).reshape(bsz, dil, nh, nb, BLK, hd)
    kb = to_sub(k, BLK).reshape(bsz, dil, nh, nb + 1, BLK, hd)
    vb = to_sub(v, BLK).reshape(bsz, dil, nh, nb + 1, BLK, hd)
    kw = jnp.concatenate([kb[:, :, :, :-1], kb[:, :, :, 1:]], axis=4)
    vw = jnp.concatenate([vb[:, :, :, :-1], vb[:, :, :, 1:]], axis=4)
    s = jnp.einsum('brhnqd,brhnkd->brhnqk', qs, kw, preferred_element_type=jnp.float32) * (hd ** -0.5)
    qi = jnp.arange(BLK)[None, :, None]
    kj = jnp.arange(2 * BLK)[None, None, :]
    blk = jnp.arange(nb)[:, None, None]
    dist = qi + BLK - kj
    valid = (dist >= 0) & (dist <= steps) & (blk * BLK + kj - BLK >= 0)
    s = jnp.where(valid, s, NEG)
    m = jnp.max(s, axis=-1, keepdims=True)
    p = jnp.exp(s - m)
    den = jnp.sum(p, axis=-1, keepdims=True)
    o = jnp.einsum('brhnqk,brhnkd->brhnqd', p, vw.astype(jnp.float32)) / den
    lse = m[..., 0] + jnp.log(den[..., 0])
    o = o.reshape(bsz, dil, nh, n_pad, hd)[:, :, :, :n].transpose(0, 3, 1, 2, 4).reshape(bsz, seq, nh, hd)
    lse = lse.reshape(bsz, dil, nh, n_pad)[..., :n].transpose(0, 3, 1, 2).reshape(bsz, seq, nh)
    return o, lse


def dilated_mixer(proj, pos):
    bsz, seq, _ = proj.shape
    parts = _split(proj, B_SIZES)
    outs, lses = [], []
    for g, (window, dil) in enumerate(DIL_PATTERNS):
        q, k, v = [parts[3 * g + j].reshape(bsz, seq, HEADS_PER_DIL, HEAD_DIM) for j in range(3)]
        o, lse = dilated_group(rope(q, pos, HEAD_DIM), rope(k, pos, HEAD_DIM), v, window, dil)
        outs.append(o)
        lses.append(lse)
    wts = jax.nn.softmax(jnp.stack(lses, axis=-1), axis=-1)
    o = jnp.sum(jnp.stack(outs, axis=-2) * wts[..., None], axis=-2)
    return o.reshape(bsz, seq, HEADS_PER_DIL * HEAD_DIM).astype(proj.dtype), parts[-1]


def memory_attention(qm, mem, g_mem, w_mem_kv):
    bsz, seq, _ = qm.shape
    kv = (rms_norm(mem, g_mem) @ w_mem_kv).reshape(bsz, mem.shape[1], 2, N_MEM_HEADS, HEAD_DIM)
    q = qm.reshape(bsz, seq, N_MEM_HEADS, HEAD_DIM)
    s = jnp.einsum('bshd,bmhd->bhsm', q, kv[:, :, 0], preferred_element_type=jnp.float32) * (HEAD_DIM ** -0.5)
    p = jax.nn.softmax(s, axis=-1)
    o = jnp.einsum('bhsm,bmhd->bshd', p, kv[:, :, 1].astype(jnp.float32))
    return o.reshape(bsz, seq, N_MEM_HEADS * HEAD_DIM).astype(qm.dtype)


def swiglu_ffn(h, w_gate_up, w_down):
    g, u = jnp.split(h @ w_gate_up, 2, axis=-1)
    return (jax.nn.silu(g) * u) @ w_down


def hybrid_layer(x, mem, pos, layer_idx, norm_mix, norm_mem, w_in, w_mem_kv, w_out,
                 norm_ffn, w_gate_up, w_down):
    proj = rms_norm(x, norm_mix) @ w_in
    if layer_idx % 2 == 0:
        mix, qm = dsa_mixer(proj, pos)
    else:
        mix, qm = dilated_mixer(proj, pos)
    mo = memory_attention(qm, mem, norm_mem, w_mem_kv)
    x = x + jnp.concatenate([mix, mo], axis=-1) @ w_out
    x = x + swiglu_ffn(rms_norm(x, norm_ffn), w_gate_up, w_down)
    return x


def setup_inputs(seed: int = 0) -> dict:
    key = jax.random.key(seed)
    ks = jax.random.split(key, 24)
    f32 = jnp.float32

    def dense(k, fi, fo):
        return jax.random.normal(k, (fi, fo), f32) * fi ** -0.5

    def gain(k):
        return 1.0 + 0.02 * jax.random.normal(k, (D_MODEL,), f32)

    x = jax.random.normal(ks[0], (BATCH, SEQ, D_MODEL), f32)
    mem = jax.random.normal(ks[1], (BATCH, MEM_TOKENS, D_MODEL), f32)
    offs = jax.random.randint(ks[2], (BATCH, 1), 0, 1024, dtype=jnp.int32)
    positions = (jnp.arange(SEQ, dtype=jnp.int32)[None, :] + offs).astype(jnp.int32)
    return {
        'x': x, 'mem': mem, 'positions': positions,
        'l0_norm_mix': gain(ks[3]), 'l0_norm_mem': gain(ks[4]),
        'l0_w_in': dense(ks[5], D_MODEL, A_IN),
        'l0_w_mem_kv': dense(ks[6], D_MODEL, 2 * N_MEM_HEADS * HEAD_DIM),
        'l0_w_out': dense(ks[7], A_OUT, D_MODEL),
        'l0_norm_ffn': gain(ks[8]),
        'l0_w_gate_up': dense(ks[9], D_MODEL, 2 * D_FF),
        'l0_w_down': dense(ks[10], D_FF, D_MODEL),
        'l1_norm_mix': gain(ks[11]), 'l1_norm_mem': gain(ks[12]),
        'l1_w_in': dense(ks[13], D_MODEL, B_IN),
        'l1_w_mem_kv': dense(ks[14], D_MODEL, 2 * N_MEM_HEADS * HEAD_DIM),
        'l1_w_out': dense(ks[15], B_OUT, D_MODEL),
        'l1_norm_ffn': gain(ks[16]),
        'l1_w_gate_up': dense(ks[17], D_MODEL, 2 * D_FF),
        'l1_w_down': dense(ks[18], D_FF, D_MODEL),
        'final_norm': gain(ks[19]),
    }


def reference(x, mem, positions,
              l0_norm_mix, l0_norm_mem, l0_w_in, l0_w_mem_kv, l0_w_out, l0_norm_ffn, l0_w_gate_up, l0_w_down,
              l1_norm_mix, l1_norm_mem, l1_w_in, l1_w_mem_kv, l1_w_out, l1_norm_ffn, l1_w_gate_up, l1_w_down,
              final_norm):
    layers = (
        (l0_norm_mix, l0_norm_mem, l0_w_in, l0_w_mem_kv, l0_w_out, l0_norm_ffn, l0_w_gate_up, l0_w_down),
        (l1_norm_mix, l1_norm_mem, l1_w_in, l1_w_mem_kv, l1_w_out, l1_norm_ffn, l1_w_gate_up, l1_w_down),
    )
    for i in range(DEPTH):
        x = hybrid_layer(x, mem, positions, i, *layers[i])
    return rms_norm(x, final_norm)
```

```cpp
#include <hip/hip_runtime.h>
#include <hip/hip_bf16.h>
#include <cstdio>
#include <cstdint>
#include <cmath>
namespace pg8 {
#define PG8_LAS __attribute__((address_space(3)))
typedef unsigned short bf16_t;
typedef short bf16x8 __attribute__((ext_vector_type(8)));
typedef float f32x4 __attribute__((ext_vector_type(4)));
typedef unsigned u32x4 __attribute__((ext_vector_type(4)));
constexpr int BM = 256, BK = 64, HALF = 128, HTB = HALF * BK * 2  , STAGE_BYTES = 8 * HTB, NXCD = 8, WGM = 8;

__host__ __device__ __forceinline__ int lds_byte(int r, int c) { const int st = (r >> 4) * 2 + (c >> 5), rr = r & 15, cc = c & 31, ob = rr * 64 + cc * 2; return st * 1024 + (ob ^ (((ob >> 9) & 1) << 5)); }
__host__ __device__ __forceinline__ void stage_rc(int b, int& R, int& C) { const int st = b / 1024, sb = b % 1024, swz = sb ^ (((sb >> 9) & 1) << 5); R = (st >> 1) * 16 + swz / 64; C = (st & 1) * 32 + (swz % 64) / 2; }
__host__ __device__ __forceinline__ int perm32(int rho) { const int n = rho >> 4, i = rho & 15; return 8 * (i >> 2) + 4 * n + (i & 3); }

struct Unit { int pm, pn; };
struct Gemm { const bf16_t* A; const bf16_t* Bt; int M, N, K; };

struct StaticOrder {
    int nM, nN, nwg, G, c;
    __host__ __device__ void init(int M, int N, int G_, int c_) { nM = M / BM; nN = N / BM; nwg = nM * nN; G = G_; c = c_; }
    __host__ __device__ bool next(int i, Unit& u) const {
        const long L = (long)i * G + c; if (L >= nwg) return false;
        int wgid = (int)L; { const int q = nwg / NXCD, r = nwg % NXCD, xcd = wgid % NXCD, off = wgid / NXCD; wgid = (xcd < r ? xcd * (q + 1) : r * (q + 1) + (xcd - r) * q) + off; }
        const int nig = WGM * nN, gid = wgid / nig, fm = gid * WGM, gsz = (nM - fm) < WGM ? (nM - fm) : WGM;
        u.pm = fm + ((wgid % nig) % gsz); u.pn = (wgid % nig) / gsz; return true;
    }
    __device__ __forceinline__ void a_ready(const Unit&) const {}
    __device__ __forceinline__ void done(const Unit&) const {}
};
__device__ __forceinline__ unsigned cvt_pk_bf16(float lo, float hi) { unsigned r; asm volatile("v_cvt_pk_bf16_f32 %0, %1, %2" : "=v"(r) : "v"(lo), "v"(hi)); return r; }
typedef float f32x2 __attribute__((ext_vector_type(2)));
typedef unsigned u32x2 __attribute__((ext_vector_type(2)));
constexpr float RMS_EPS = 1e-6f;
constexpr float ATT_C2 = 0.125f * 1.4426950408889634f;
__device__ __forceinline__ float rstd_of(const float* ss, int row) {
    const f32x4* p = (const f32x4*)(ss + (size_t)row * 16);
    const f32x4 a = p[0], b = p[1], c = p[2], d = p[3];
    const float s = (((a[0] + a[1]) + (a[2] + a[3])) + ((b[0] + b[1]) + (b[2] + b[3]))) + (((c[0] + c[1]) + (c[2] + c[3])) + ((d[0] + d[1]) + (d[2] + d[3])));
    return __builtin_amdgcn_rsqf(s * (1.0f / 1024.0f) + RMS_EPS);
}
__device__ __forceinline__ float bf_lo(unsigned w) { return __builtin_bit_cast(float, w << 16); }
__device__ __forceinline__ float bf_hi(unsigned w) { return __builtin_bit_cast(float, w & 0xffff0000u); }
__device__ __forceinline__ float silu_mul(float g, float u) { return g * __builtin_amdgcn_rcpf(1.0f + __builtin_amdgcn_exp2f(-1.4426950408889634f * g)) * u; }

struct EpiGateUp {
    static constexpr bool PERM = true, AFTER_DRAIN = false;
    bf16_t* H; const float* ss; int ldh;
    __device__ __forceinline__ void operator()(const f32x4 (&acc)[2][2][4][2], const Unit& u, int wr, int wc, int fr, int fq) const {
        const int row0 = u.pm * BM + wr * 64 + fr, col0 = u.pn * HALF + wc * 32 + 8 * fq;
#pragma unroll
        for (int ai = 0; ai < 2; ++ai)
#pragma unroll
            for (int m = 0; m < 4; ++m) {
                const int row = row0 + ai * HALF + m * 16; const float rs = rstd_of(ss, row);
                const f32x4 g0 = acc[ai][0][m][0] * rs, g1 = acc[ai][0][m][1] * rs, u0 = acc[ai][1][m][0] * rs, u1 = acc[ai][1][m][1] * rs;
                u32x4 w;
                w.x = cvt_pk_bf16(silu_mul(g0[0], u0[0]), silu_mul(g0[1], u0[1])); w.y = cvt_pk_bf16(silu_mul(g0[2], u0[2]), silu_mul(g0[3], u0[3]));
                w.z = cvt_pk_bf16(silu_mul(g1[0], u1[0]), silu_mul(g1[1], u1[1])); w.w = cvt_pk_bf16(silu_mul(g1[2], u1[2]), silu_mul(g1[3], u1[3]));
                *(u32x4*)(H + (size_t)row * ldh + col0) = w;
            }
    }
};
template <bool F32OUT> struct EpiResid {
    static constexpr bool PERM = true, AFTER_DRAIN = false;
    bf16_t* X; float* out; float* ss;
    __device__ __forceinline__ void operator()(const f32x4 (&acc)[2][2][4][2], const Unit& u, int wr, int wc, int fr, int fq) const {
        const int row0 = u.pm * BM + wr * 64 + fr, col0 = u.pn * BM + wc * 32 + 8 * fq;
#pragma unroll
        for (int ai = 0; ai < 2; ++ai)
#pragma unroll
            for (int m = 0; m < 4; ++m) {
                const int row = row0 + ai * HALF + m * 16; float q = 0.f;
#pragma unroll
                for (int bj = 0; bj < 2; ++bj) {
                    bf16_t* xp = X + (size_t)row * 1024 + col0 + bj * HALF;
                    const u32x4 xv = *(const u32x4*)xp;
                    f32x4 v0, v1;
                    v0[0] = bf_lo(xv.x) + acc[ai][bj][m][0][0]; v0[1] = bf_hi(xv.x) + acc[ai][bj][m][0][1]; v0[2] = bf_lo(xv.y) + acc[ai][bj][m][0][2]; v0[3] = bf_hi(xv.y) + acc[ai][bj][m][0][3];
                    v1[0] = bf_lo(xv.z) + acc[ai][bj][m][1][0]; v1[1] = bf_hi(xv.z) + acc[ai][bj][m][1][1]; v1[2] = bf_lo(xv.w) + acc[ai][bj][m][1][2]; v1[3] = bf_hi(xv.w) + acc[ai][bj][m][1][3];
                    q += (v0[0] * v0[0] + v0[1] * v0[1]) + (v0[2] * v0[2] + v0[3] * v0[3]) + (v1[0] * v1[0] + v1[1] * v1[1]) + (v1[2] * v1[2] + v1[3] * v1[3]);
                    if (F32OUT) { float* op = out + (size_t)row * 1024 + col0 + bj * HALF; *(f32x4*)op = v0; *(f32x4*)(op + 4) = v1; }
                    else { u32x4 w; w.x = cvt_pk_bf16(v0[0], v0[1]); w.y = cvt_pk_bf16(v0[2], v0[3]); w.z = cvt_pk_bf16(v1[0], v1[1]); w.w = cvt_pk_bf16(v1[2], v1[3]); *(u32x4*)xp = w; }
                }
                q += __shfl_xor(q, 16); q += __shfl_xor(q, 32);
                if (fq == 0) ss[(size_t)row * 16 + u.pn * 4 + wc] = q;
            }
    }
};
struct EpiScaled {
    static constexpr bool PERM = true, AFTER_DRAIN = false;
    bf16_t* O; const float* ss; int ldo;
    __device__ __forceinline__ void operator()(const f32x4 (&acc)[2][2][4][2], const Unit& u, int wr, int wc, int fr, int fq) const {
        const int row0 = u.pm * BM + wr * 64 + fr, col0 = u.pn * BM + wc * 32 + 8 * fq;
#pragma unroll
        for (int ai = 0; ai < 2; ++ai)
#pragma unroll
            for (int m = 0; m < 4; ++m) {
                const int row = row0 + ai * HALF + m * 16; const float rs = rstd_of(ss, row);
#pragma unroll
                for (int bj = 0; bj < 2; ++bj) { const f32x4 v0 = acc[ai][bj][m][0] * rs, v1 = acc[ai][bj][m][1] * rs;
                    u32x4 w; w.x = cvt_pk_bf16(v0[0], v0[1]); w.y = cvt_pk_bf16(v0[2], v0[3]); w.z = cvt_pk_bf16(v1[0], v1[1]); w.w = cvt_pk_bf16(v1[2], v1[3]);
                    *(u32x4*)(O + (size_t)row * ldo + col0 + bj * HALF) = w; }
            }
    }
};
__device__ __forceinline__ void st4(bf16_t* p, const f32x4 v) { u32x2 w; w.x = cvt_pk_bf16(v[0], v[1]); w.y = cvt_pk_bf16(v[2], v[3]); *(u32x2*)p = w; }
__device__ __forceinline__ void rope64(f32x4& a0, f32x4& a1, const float* cs, const float* sn, int row, int d) {
    const f32x4 c = *(const f32x4*)(cs + (size_t)row * 32 + d), s = *(const f32x4*)(sn + (size_t)row * 32 + d);
    const f32x4 r0 = a0 * c - a1 * s, r1 = a1 * c + a0 * s; a0 = r0; a1 = r1;
}
__device__ __forceinline__ void rope32(f32x4& a0, f32x4& a1, const float* cs, const float* sn, int row, int d) {
    const f32x4 ca = *(const f32x4*)(cs + (size_t)row * 32 + 2 * d), cb = *(const f32x4*)(cs + (size_t)row * 32 + 2 * d + 4);
    const f32x4 sa = *(const f32x4*)(sn + (size_t)row * 32 + 2 * d), sb = *(const f32x4*)(sn + (size_t)row * 32 + 2 * d + 4);
    const f32x4 c = {ca[0], ca[2], cb[0], cb[2]}, s = {sa[0], sa[2], sb[0], sb[2]};
    const f32x4 r0 = a0 * c - a1 * s, r1 = a1 * c + a0 * s; a0 = r0; a1 = r1;
}
struct EpiWin0 {
    static constexpr bool PERM = false, AFTER_DRAIN = false;
    const float* ss; const float* cs; const float* sn;
    bf16_t *Q, *K, *V, *QI, *KI, *QM; float* WI;
    __device__ __forceinline__ void operator()(const f32x4 (&acc)[2][2][4][2], const Unit& u, int wr, int wc, int fr, int fq) const {
        const int row0 = u.pm * BM + wr * 64 + fr, pn = u.pn, w = wc & 1;
#pragma unroll
        for (int ai = 0; ai < 2; ++ai)
#pragma unroll
            for (int m = 0; m < 4; ++m) {
                const int row = row0 + ai * HALF + m * 16; const float rs = rstd_of(ss, row);
#pragma unroll
                for (int bj = 0; bj < 2; ++bj) {
                    f32x4 a0 = acc[ai][bj][m][0] * rs, a1 = acc[ai][bj][m][1] * rs;
                    const int hl = 2 * bj + (wc >> 1);
                    const int nat = bj * HALF + wc * 32 + 4 * fq;
                    if (pn < 4) {
                        const int d = 16 * w + 4 * fq; rope64(a0, a1, cs, sn, row, d);
                        if (pn < 3) { a0 = a0 * ATT_C2; a1 = a1 * ATT_C2; bf16_t* p = Q + (size_t)row * 768 + pn * 256 + hl * 64 + d; st4(p, a0); st4(p + 32, a1); }
                        else { bf16_t* p = K + (size_t)row * 256 + hl * 64 + d; st4(p, a0); st4(p + 32, a1); }
                    } else if (pn == 4) { bf16_t* p = V + (size_t)row * 256 + nat; st4(p, a0); st4(p + 16, a1);
                    } else if (pn < 7) {
                        if (w == 0) rope32(a0, a1, cs, sn, row, 4 * fq);
                        bf16_t* p = QI + (size_t)row * 512 + (pn - 5) * 256 + nat; st4(p, a0); st4(p + 16, a1);
                    } else if (pn == 7) { a0 = a0 * ATT_C2; a1 = a1 * ATT_C2; bf16_t* p = QM + (size_t)row * 256 + nat; st4(p, a0); st4(p + 16, a1);
                    } else if (bj == 0) {
                        if (wc < 2) { if (w == 0) rope32(a0, a1, cs, sn, row, 4 * fq); bf16_t* p = KI + (size_t)row * 64 + wc * 32 + 4 * fq; st4(p, a0); st4(p + 16, a1); }
                        else if (wc == 2 && fq < 2) { *(f32x4*)(WI + (size_t)row * 8 + 4 * fq) = a0 * 0.04419417382415922f; }
                    }
                }
            }
    }
};
struct EpiWin1 {
    static constexpr bool PERM = false, AFTER_DRAIN = false;
    const float* ss; const float* cs; const float* sn; bf16_t* P1;
    __device__ __forceinline__ void operator()(const f32x4 (&acc)[2][2][4][2], const Unit& u, int wr, int wc, int fr, int fq) const {
        const int row0 = u.pm * BM + wr * 64 + fr, pn = u.pn, w = wc & 1;
        const bool rope = (pn < 9) && (pn % 3 != 2), qscale = (pn == 9) || (pn < 9 && pn % 3 == 0);
#pragma unroll
        for (int ai = 0; ai < 2; ++ai)
#pragma unroll
            for (int m = 0; m < 4; ++m) {
                const int row = row0 + ai * HALF + m * 16; const float rs = rstd_of(ss, row) * (qscale ? ATT_C2 : 1.0f);
#pragma unroll
                for (int bj = 0; bj < 2; ++bj) {
                    f32x4 a0 = acc[ai][bj][m][0] * rs, a1 = acc[ai][bj][m][1] * rs;
                    if (rope) { const int hl = 2 * bj + (wc >> 1), d = 16 * w + 4 * fq; rope64(a0, a1, cs, sn, row, d);
                        bf16_t* p = P1 + (size_t)row * 2560 + pn * 256 + hl * 64 + d; st4(p, a0); st4(p + 32, a1); }
                    else { bf16_t* p = P1 + (size_t)row * 2560 + pn * 256 + bj * HALF + wc * 32 + 4 * fq; st4(p, a0); st4(p + 16, a1); }
                }
            }
    }
};
struct ShiftOrder {
    StaticOrder so; bool on;
    __device__ void init(int M, int N, int G, int c, int shift) { const int cc = (c - shift + 4 * G) % G; so.init(M, N, G, cc); on = true; }
    __device__ bool next(int i, Unit& u) const { return so.next(i, u); }
    __device__ __forceinline__ void a_ready(const Unit&) const {}
    __device__ __forceinline__ void done(const Unit&) const {}
};
template <class Epi, class Sched, bool ALIGN_EPI = false, bool SP2 = false>
__device__ __forceinline__ void gemm_phase(PG8_LAS unsigned char* lds, const Gemm g, const Sched& S, const Epi& E) {
    const int tid = threadIdx.x, wid = __builtin_amdgcn_readfirstlane(tid >> 6), lane = tid & 63, wr = wid >> 2, wc = wid & 3, fr = lane & 15, fq = lane >> 4;
    const int K = g.K, nt = K / BK;
    unsigned voffA[2], voffB[2];
#pragma unroll
    for (int i = 0; i < 2; ++i) { int R, C; stage_rc(tid * 16 + i * 8192, R, C); const int Rb = Epi::PERM ? ((R & ~31) + perm32(R & 31)) : R;
        voffA[i] = (unsigned)(R * K + C) * 2u; voffB[i] = (unsigned)(Rb * K + C) * 2u; }
    const size_t kstep = (size_t)(BK * 2);
    const size_t hstep = (size_t)HALF * K * 2;
    const size_t tstep = 2 * hstep;
    const unsigned ldsw = (unsigned)wid * 1024u;
    const int aoff = lds_byte(wr * 64 + fr, fq * 8), boff = lds_byte(wc * 32 + fr, fq * 8);
#define PG8_SA(b, h) (((b) * 2 + (h)) * HTB)
#define PG8_SB(b, h) ((4 + (b) * 2 + (h)) * HTB)
#define PG8_STAGE(bufoff, gbase, voff) do { _Pragma("unroll") for (int _i = 0; _i < 2; ++_i) \
        __builtin_amdgcn_global_load_lds((const unsigned*)((const char*)(gbase) + (voff)[_i]), (PG8_LAS unsigned*)(lds + (bufoff) + ldsw + _i * 8192), 16, 0, 0); } while (0)
#define PG8_LDA(dst, b, h) do { _Pragma("unroll") for (int m = 0; m < 4; ++m) _Pragma("unroll") for (int k = 0; k < 2; ++k) dst[m][k] = *(const PG8_LAS bf16x8*)(lds + PG8_SA(b, h) + aoff + m * 2048 + k * 1024); } while (0)
#define PG8_LDB(dst, b, h) do { _Pragma("unroll") for (int n = 0; n < 2; ++n) _Pragma("unroll") for (int k = 0; k < 2; ++k) dst[n][k] = *(const PG8_LAS bf16x8*)(lds + PG8_SB(b, h) + boff + n * 2048 + k * 1024); } while (0)
#define PG8_MMA(ai, bj, At, Bt) do { __builtin_amdgcn_s_setprio(1); _Pragma("unroll") for (int m = 0; m < 4; ++m) _Pragma("unroll") for (int n = 0; n < 2; ++n) _Pragma("unroll") for (int k = 0; k < 2; ++k) \
        acc[ai][bj][m][n] = __builtin_amdgcn_mfma_f32_16x16x32_bf16(Bt[n][k], At[m][k], acc[ai][bj][m][n], 0, 0, 0); __builtin_amdgcn_s_setprio(0); } while (0)
#define PG8_WAIT_V(n) asm volatile("s_waitcnt vmcnt(" #n ")" ::: "memory")
#define PG8_WAIT_L(n) asm volatile("s_waitcnt lgkmcnt(" #n ")" ::: "memory")
#define PG8_BAR __builtin_amdgcn_s_barrier()
#define PG8_SCHED __builtin_amdgcn_sched_barrier(0)
    Unit cur, nxt; int ui = 0;
    if (!S.next(0, cur)) return;
    f32x4 acc[2][2][4][2];
#pragma unroll
    for (int a = 0; a < 2; ++a)
#pragma unroll
        for (int b = 0; b < 2; ++b)
#pragma unroll
            for (int m = 0; m < 4; ++m)
#pragma unroll
                for (int n = 0; n < 2; ++n) acc[a][b][m][n] = (f32x4){0.f, 0.f, 0.f, 0.f};
    bf16x8 At[4][2], B0[2][2], B1[2][2];
    const char* cA = (const char*)g.A + (size_t)cur.pm * tstep; const char* cB = (const char*)g.Bt + (size_t)cur.pn * tstep;
    S.a_ready(cur);
    if constexpr (SP2) {
        PG8_STAGE(PG8_SB(0, 0), cB, voffB); PG8_STAGE(PG8_SB(0, 1), cB + hstep, voffB); PG8_STAGE(PG8_SA(0, 0), cA, voffA); PG8_STAGE(PG8_SA(0, 1), cA + hstep, voffA);
        if (wr == 1) PG8_BAR;
        PG8_WAIT_V(2); PG8_BAR;
        PG8_STAGE(PG8_SB(1, 0), cB + kstep, voffB); PG8_STAGE(PG8_SA(1, 0), cA + kstep, voffA); PG8_STAGE(PG8_SB(1, 1), cB + hstep + kstep, voffB);
        PG8_WAIT_V(6); PG8_BAR;
    } else {
        PG8_STAGE(PG8_SB(0, 0), cB, voffB); PG8_STAGE(PG8_SA(0, 0), cA, voffA); PG8_STAGE(PG8_SB(0, 1), cB + hstep, voffB); PG8_STAGE(PG8_SA(0, 1), cA + hstep, voffA);
        if (wr == 1) PG8_BAR;
        PG8_WAIT_V(4); PG8_BAR;
        PG8_STAGE(PG8_SB(1, 0), cB + kstep, voffB); PG8_STAGE(PG8_SA(1, 0), cA + kstep, voffA); PG8_STAGE(PG8_SB(1, 1), cB + hstep + kstep, voffB);
        PG8_WAIT_V(6); PG8_BAR;
    }
    for (;;) {
        const bool has_next = S.next(ui + 1, nxt);
        const char* nA = has_next ? (const char*)g.A + (size_t)nxt.pm * tstep : cA; const char* nB = has_next ? (const char*)g.Bt + (size_t)nxt.pn * tstep : cB;
        for (int t = 0; t < nt; t += 2) {
            const bool last = (t == nt - 2);
            const char* a1 = cA + (size_t)(t + 1) * kstep;
            const char* a2 = last ? nA : cA + (size_t)(t + 2) * kstep; const char* b2 = last ? nB : cB + (size_t)(t + 2) * kstep;
            const char* a3 = a2 + kstep; const char* b3 = b2 + kstep;
            if (last && has_next) S.a_ready(nxt);
            if constexpr (SP2) {
            PG8_LDB(B0, 0, 0); PG8_LDB(B1, 0, 1); PG8_SCHED; PG8_LDA(At, 0, 0); PG8_STAGE(PG8_SA(1, 1), a1 + hstep, voffA);
            PG8_WAIT_V(8); PG8_WAIT_L(0); PG8_BAR; PG8_MMA(0, 0, At, B0); PG8_MMA(0, 1, At, B1); PG8_BAR; PG8_SCHED;
            PG8_LDA(At, 0, 1); PG8_STAGE(PG8_SB(0, 0), b2, voffB); PG8_STAGE(PG8_SB(0, 1), b2 + hstep, voffB); PG8_STAGE(PG8_SA(0, 0), a2, voffA);
            PG8_WAIT_V(8); PG8_WAIT_L(0); PG8_BAR; PG8_MMA(1, 0, At, B0); PG8_MMA(1, 1, At, B1); PG8_BAR; PG8_SCHED;
            PG8_LDB(B0, 1, 0); PG8_LDB(B1, 1, 1); PG8_SCHED; PG8_LDA(At, 1, 0); PG8_STAGE(PG8_SA(0, 1), a2 + hstep, voffA);
            PG8_WAIT_V(8); PG8_WAIT_L(0); PG8_BAR; PG8_MMA(0, 0, At, B0); PG8_MMA(0, 1, At, B1); PG8_BAR; PG8_SCHED;
            PG8_LDA(At, 1, 1); PG8_STAGE(PG8_SB(1, 0), b3, voffB); PG8_STAGE(PG8_SB(1, 1), b3 + hstep, voffB); PG8_STAGE(PG8_SA(1, 0), a3, voffA);
            PG8_WAIT_V(8); PG8_WAIT_L(0); PG8_BAR; PG8_MMA(1, 0, At, B0); PG8_MMA(1, 1, At, B1); PG8_BAR; PG8_SCHED;
            } else {
            PG8_LDB(B0, 0, 0); PG8_SCHED; PG8_LDA(At, 0, 0); PG8_STAGE(PG8_SA(1, 1), a1 + hstep, voffA);
            PG8_WAIT_L(8); PG8_BAR; PG8_WAIT_L(0); PG8_MMA(0, 0, At, B0); PG8_BAR; PG8_SCHED;
            PG8_LDB(B1, 0, 1); PG8_STAGE(PG8_SB(0, 0), b2, voffB);
            PG8_BAR; PG8_WAIT_L(0); PG8_MMA(0, 1, At, B1); PG8_BAR;
            PG8_LDA(At, 0, 1); PG8_STAGE(PG8_SA(0, 0), a2, voffA);
            PG8_BAR; PG8_WAIT_L(0); PG8_MMA(1, 0, At, B0); PG8_BAR; PG8_SCHED;
            PG8_STAGE(PG8_SB(0, 1), b2 + hstep, voffB);
            PG8_WAIT_V(6); PG8_BAR; PG8_MMA(1, 1, At, B1); PG8_BAR;
            PG8_LDB(B0, 1, 0); PG8_SCHED; PG8_LDA(At, 1, 0); PG8_STAGE(PG8_SA(0, 1), a2 + hstep, voffA);
            PG8_WAIT_L(8); PG8_BAR; PG8_WAIT_L(0); PG8_MMA(0, 0, At, B0); PG8_BAR; PG8_SCHED;
            PG8_LDB(B1, 1, 1); PG8_STAGE(PG8_SB(1, 0), b3, voffB);
            PG8_BAR; PG8_WAIT_L(0); PG8_MMA(0, 1, At, B1); PG8_BAR;
            PG8_LDA(At, 1, 1); PG8_STAGE(PG8_SA(1, 0), a3, voffA);
            PG8_BAR; PG8_WAIT_L(0); PG8_MMA(1, 0, At, B0); PG8_BAR; PG8_SCHED;
            PG8_STAGE(PG8_SB(1, 1), b3 + hstep, voffB);
            PG8_WAIT_V(6); PG8_BAR; PG8_MMA(1, 1, At, B1); PG8_BAR;
            }
        }
        if constexpr (ALIGN_EPI) { if (wr == 0) PG8_BAR; }
        if constexpr (!Epi::AFTER_DRAIN) { E(acc, cur, wr, wc, fr, fq); S.done(cur); }
        if (!has_next) break;
#pragma unroll
        for (int a = 0; a < 2; ++a)
#pragma unroll
            for (int b = 0; b < 2; ++b)
#pragma unroll
                for (int m = 0; m < 4; ++m)
#pragma unroll
                    for (int n = 0; n < 2; ++n) acc[a][b][m][n] = (f32x4){0.f, 0.f, 0.f, 0.f};
        cur = nxt; cA = nA; cB = nB; ++ui;
        if constexpr (ALIGN_EPI) { if (wr == 1) PG8_BAR; }
    }
    PG8_WAIT_V(0);
    if constexpr (!ALIGN_EPI) { if (wr == 0) PG8_BAR; }
    PG8_BAR;
    if constexpr (Epi::AFTER_DRAIN) { E.fused(acc, cur, wr, wc, fr, fq, lds, wid, lane); S.done(cur); }
#undef PG8_SA
#undef PG8_SB
#undef PG8_STAGE
#undef PG8_LDA
#undef PG8_LDB
#undef PG8_MMA
#undef PG8_WAIT_V
#undef PG8_WAIT_L
#undef PG8_BAR
#undef PG8_SCHED
}
}
namespace attn_body {
using bf16=__hip_bfloat16;
using bf16x8=__attribute__((ext_vector_type(8)))short;
using s16x4=__attribute__((ext_vector_type(4)))short;
using f32x16=__attribute__((ext_vector_type(16)))float;
using u32x4=__attribute__((ext_vector_type(4)))unsigned;
constexpr int D=64;
constexpr int NW=8,QBLK=32,QB=QBLK*NW,KVBLK=64;
enum { MODE_MEM=0, MODE_DSA=1, MODE_DIL=2 };
struct AttnDesc { const __hip_bfloat16* Q; long qs; const __hip_bfloat16* K; const __hip_bfloat16* V; long ks; __hip_bfloat16* O; long os; int NT;
                  const unsigned* msk;
                  int dq0;
                  float* lse; long lses; };
__device__ __forceinline__ int crow(int r,int hi){return (r&3)+8*(r>>2)+4*hi;}
#define SBAR() __builtin_amdgcn_sched_barrier(0)
__device__ __forceinline__ void bmask(f32x16&p0,f32x16&p1,unsigned w0,unsigned w1,int hi){
  const float NEG=-INFINITY; const unsigned a=w0>>(4*hi), b=w1>>(4*hi);
  #pragma unroll
  for(int r=0;r<16;++r){const unsigned bit=1u<<((r&3)+8*(r>>2)); if(!(a&bit))p0[r]=NEG; if(!(b&bit))p1[r]=NEG;}
}
__device__ __forceinline__ void dmask(f32x16&p0,f32x16&p1,int base){
  const float NEG=-INFINITY;
  #pragma unroll
  for(int r=0;r<16;++r){const int df=base-((r&3)+8*(r>>2)); if((unsigned)df>128u)p0[r]=NEG; if((unsigned)(df-32)>128u)p1[r]=NEG;}
}

constexpr int NSLOT=3, SLOTB=8192;
constexpr int LDS_K=0, LDS_V=NSLOT*SLOTB, LDS_WS=2*NSLOT*SLOTB, LDS_OST=LDS_WS+NW*64*4, LDS_BYTES=LDS_OST+NW*4096;
constexpr float C2=0.125f*1.4426950408889634f;
__device__ __forceinline__ void glds16(const void*gsrc,unsigned lds_dst){unsigned keep;
  asm volatile("s_mov_b32 %0, m0\n\ts_mov_b32 m0, %2\n\ts_nop 0\n\tglobal_load_lds_dwordx4 %1, off\n\ts_mov_b32 m0, %0":"=&s"(keep):"v"(gsrc),"s"(lds_dst):"memory");}
__device__ __forceinline__ float max3f(float a,float b,float c){float r;asm("v_max3_f32 %0, %1, %2, %3":"=v"(r):"v"(a),"v"(b),"v"(c));return r;}
__device__ __forceinline__ float max2f(float a,float b){float r;asm("v_max_f32_e32 %0, %1, %2":"=v"(r):"v"(a),"v"(b));return r;}
__device__ __forceinline__ float fadd_s(float a,float b){float r;asm("v_add_f32_e32 %0, %1, %2":"=v"(r):"v"(a),"v"(b));return r;}
__device__ __forceinline__ float fsub_s(float a,float b){float r;asm("v_sub_f32_e32 %0, %1, %2":"=v"(r):"v"(a),"v"(b));return r;}
typedef float f32x2_t __attribute__((ext_vector_type(2))); typedef __bf16 bf16x2_t __attribute__((ext_vector_type(2)));
__device__ __forceinline__ unsigned cvtpk_s(float lo,float hi){f32x2_t v={lo,hi};bf16x2_t b=__builtin_convertvector(v,bf16x2_t);return __builtin_bit_cast(unsigned,b);}
#define WAIT_BAR(N) asm volatile("s_waitcnt vmcnt(" #N ") lgkmcnt(0)\n\ts_barrier":::"memory")

__device__ __forceinline__ void qkt(f32x16&p0,f32x16&p1,const char*Kslot,const bf16x8*qr,const f32x16&negm,int r32,int hi){
  const char*kb=Kslot+hi*1024+r32*16;
  #pragma unroll
  for(int d0=0;d0<4;++d0){
    const bf16x8 b0=*reinterpret_cast<const bf16x8*>(kb+d0*2048);
    const bf16x8 b1=*reinterpret_cast<const bf16x8*>(kb+d0*2048+512);
    if(d0==0){p0=__builtin_amdgcn_mfma_f32_32x32x16_bf16(b0,qr[0],negm,0,0,0);p1=__builtin_amdgcn_mfma_f32_32x32x16_bf16(b1,qr[0],negm,0,0,0);}
    else{p0=__builtin_amdgcn_mfma_f32_32x32x16_bf16(b0,qr[d0],p0,0,0,0);p1=__builtin_amdgcn_mfma_f32_32x32x16_bf16(b1,qr[d0],p1,0,0,0);}}
}
typedef __attribute__((address_space(3))) const char* lds_cptr;
typedef short v4i16_t __attribute__((ext_vector_type(4)));
__device__ __forceinline__ void kload8(bf16x8*kf,lds_cptr kp){
  kf[0]=*(const __attribute__((address_space(3))) bf16x8*)(kp);      kf[1]=*(const __attribute__((address_space(3))) bf16x8*)(kp+512);
  kf[2]=*(const __attribute__((address_space(3))) bf16x8*)(kp+2048); kf[3]=*(const __attribute__((address_space(3))) bf16x8*)(kp+2560);
  kf[4]=*(const __attribute__((address_space(3))) bf16x8*)(kp+4096); kf[5]=*(const __attribute__((address_space(3))) bf16x8*)(kp+4608);
  kf[6]=*(const __attribute__((address_space(3))) bf16x8*)(kp+6144); kf[7]=*(const __attribute__((address_space(3))) bf16x8*)(kp+6656);
}
__device__ __forceinline__ void kload2(bf16x8*kf,lds_cptr kp,int j){ kf[2*j]=*(const __attribute__((address_space(3))) bf16x8*)(kp+j*2048); kf[2*j+1]=*(const __attribute__((address_space(3))) bf16x8*)(kp+j*2048+512); }
__device__ __forceinline__ s16x4 vtr(lds_cptr p){ return __builtin_bit_cast(s16x4,__builtin_amdgcn_ds_read_tr16_b64_v4i16((__attribute__((address_space(3))) v4i16_t*)p)); }
__device__ __forceinline__ float rowmax(const f32x16&p0,const f32x16&p1){
  float a=max3f(p0[0],p0[1],p1[0]),b=max3f(p0[2],p0[3],p1[1]);a=max3f(a,p1[2],p1[3]);
  #pragma unroll
  for(int r=4;r<16;r+=4){a=max3f(a,p0[r],p0[r+1]);b=max3f(b,p0[r+2],p0[r+3]);a=max3f(a,p1[r],p1[r+1]);b=max3f(b,p1[r+2],p1[r+3]);}
  const float m=max2f(a,b);
  auto rr=__builtin_amdgcn_permlane32_swap(__float_as_uint(m),__float_as_uint(m),false,false);
  return max2f(__uint_as_float(rr[0]),__uint_as_float(rr[1]));
}
__device__ __forceinline__ void pv(f32x16*o,int vb,bf16x8 pa0,bf16x8 pa1,bf16x8 pa2,bf16x8 pa3){
  #pragma unroll
  for(int d0=0;d0<2;++d0){s16x4 lo[4],hi[4];
    #pragma unroll
    for(int ks=0;ks<4;++ks){
      asm volatile("ds_read_b64_tr_b16 %0,%1 offset:%c2":"=&v"(lo[ks]):"v"(vb),"i"(d0*4096+ks*1024):"memory");
      asm volatile("ds_read_b64_tr_b16 %0,%1 offset:%c2":"=&v"(hi[ks]):"v"(vb),"i"(d0*4096+ks*1024+512):"memory");}
    asm volatile("s_waitcnt lgkmcnt(0)":::"memory");SBAR();
    #define PK(k) (bf16x8){lo[k][0],lo[k][1],lo[k][2],lo[k][3],hi[k][0],hi[k][1],hi[k][2],hi[k][3]}
    o[d0]=__builtin_amdgcn_mfma_f32_32x32x16_bf16(pa0,PK(0),o[d0],0,0,0);
    o[d0]=__builtin_amdgcn_mfma_f32_32x32x16_bf16(pa1,PK(1),o[d0],0,0,0);
    o[d0]=__builtin_amdgcn_mfma_f32_32x32x16_bf16(pa2,PK(2),o[d0],0,0,0);
    o[d0]=__builtin_amdgcn_mfma_f32_32x32x16_bf16(pa3,PK(3),o[d0],0,0,0);
    #undef PK
  }
}

#ifndef ATTN_STORE16
#define ATTN_STORE16(p,v) (*(u32x4*)(p)=(v))
#endif
template<int MODE,int THRL> __device__ __forceinline__ void attn_unit(const AttnDesc&ds,char*shm){
  const int tid=threadIdx.x,lane=tid&63,r32=lane&31,hi=lane>>5; const int wid=__builtin_amdgcn_readfirstlane(tid>>6);
  const long QS=ds.qs,KS=ds.ks,OS=ds.os;
  const bf16*Qw=ds.Q+(long)(wid*QBLK)*QS;
  const bf16*Kh=ds.K,*Vh=ds.V;
  const unsigned lds0=(unsigned)(uintptr_t)shm;
  float*wsf=(float*)(shm+LDS_WS)+wid*64;
  const bf16*ksrc=Kh+(long)lane*KS+wid*8;
  const bf16*vsrc=Vh+(long)(16*(wid&3)+(lane>>2))*KS+(wid>>2)*32+(lane&3)*8;
  const unsigned kdst=lds0+LDS_K+wid*1024, vdst=lds0+LDS_V+wid*1024;
  #define DMA_K(t,slot) glds16(ksrc+(long)(t)*KVBLK*KS,(unsigned)__builtin_amdgcn_readfirstlane(kdst+(slot)))
  #define DMA_V(t,slot) glds16(vsrc+(long)(t)*KVBLK*KS,(unsigned)__builtin_amdgcn_readfirstlane(vdst+(slot)))
  const int vb0=(int)(lds0+LDS_V)+((lane>>4)&1)*32+(lane&3)*8+(4*hi+((lane&15)>>2))*64;
  const char*Kbase=shm+LDS_K; bf16x8 kf[8];
  const lds_cptr shm3=(lds_cptr)shm; const lds_cptr kp0=shm3+LDS_K+hi*1024+r32*16; const lds_cptr vp0=shm3+LDS_V+((lane>>4)&1)*32+(lane&3)*8+(4*hi+((lane&15)>>2))*64;
  const int NT=ds.NT;
  DMA_K(0,0);DMA_V(0,0);DMA_K(1,SLOTB);
  bf16x8 qr[4];
  #pragma unroll
  for(int d0=0;d0<4;++d0)qr[d0]=*reinterpret_cast<const bf16x8*>(&Qw[(long)r32*QS+d0*16+hi*8]);
  float mhat=0.f,l_reg=0.f;f32x16 o[2];o[0]=f32x16{};o[1]=f32x16{};f32x16 negm=f32x16{};asm volatile("":"+v"(negm));
  const int qrel=wid*QBLK+r32;
  const unsigned*mp=(MODE==MODE_DSA)?ds.msk+qrel:nullptr; const int dqb=ds.dq0+qrel-4*hi;
  unsigned mc0=0u,mc1=0u,mn0=0u,mn1=0u;
  #define MLOAD(t) do{ if(MODE==MODE_DSA){ mn0=mp[(long)(2*(t))*4096]; mn1=mp[(long)(2*(t)+1)*4096]; } }while(0)
  #define MROT() do{ if(MODE==MODE_DSA){ mc0=mn0; mc1=mn1; } }while(0)
  #define CMASK(P0,P1,t) do{ if(MODE==MODE_DSA)bmask(P0,P1,mc0,mc1,hi); else if(MODE==MODE_DIL)dmask(P0,P1,dqb-64*(t)); }while(0)
  MLOAD(0); MROT(); MLOAD(1);
  bool resc=false;
  #define START(P0,P1) do{ const float rm=rowmax(P0,P1); resc=false; \
    { const float dl=(rm>-1e30f)?rm:0.f; mhat=fadd_s(mhat,dl); \
      _Pragma("unroll") for(int r=0;r<16;++r){P0[r]=fsub_s(P0[r],dl);P1[r]=fsub_s(P1[r],dl);} \
      _Pragma("unroll") for(int r=0;r<16;++r)negm[r]=-mhat; asm volatile("":"+v"(negm)); } \
    _Pragma("unroll") for(int r=0;r<16;++r)P0[r]=__builtin_amdgcn_exp2f(P0[r]); }while(0)
  #define RESC() do{ if(resc){ asm volatile("s_waitcnt lgkmcnt(0)":::"memory"); \
      _Pragma("unroll") for(int d_=0;d_<2;++d_) _Pragma("unroll") for(int r=0;r<16;++r)o[d_][r]*=wsf[crow(r,hi)]; } }while(0)
  f32x16 pA0,pA1,pB0,pB1;
  int sl_prev=0,sl_cur=0,sl_next=SLOTB;
  #define ROT() do{sl_prev=sl_cur;sl_cur=sl_next;sl_next=(sl_next==(NSLOT-1)*SLOTB)?0:sl_next+SLOTB;}while(0)
  DMA_K(2,2*SLOTB);
  WAIT_BAR(3);
  qkt(pA0,pA1,Kbase,qr,negm,r32,hi);asm volatile("s_nop 15\n\ts_nop 7":"+v"(pA0),"+v"(pA1));CMASK(pA0,pA1,0);
  START(pA0,pA1);
  _Pragma("unroll") for(int r=0;r<16;++r)pA1[r]=__builtin_amdgcn_exp2f(pA1[r]);
  WAIT_BAR(0);
  DMA_K(3,0);DMA_V(1,SLOTB);
  ROT();
  kload8(kf,kp0+sl_cur);
  WAIT_BAR(2);
  s16x4 vlo[8],vhi[8]; u32x4 pw0,pw1,pw2,pw3;
  #define PKW(P,B) cvtpk_s(P[B],P[B+1])
  #define PAF(k) __builtin_bit_cast(bf16x8,pw##k)
  #define VFR(i) (bf16x8){vlo[i][0],vlo[i][1],vlo[i][2],vlo[i][3],vhi[i][0],vhi[i][1],vhi[i][2],vhi[i][3]}
  #define PIN(x) asm volatile("":"+v"(x))
  #define MX3(a,b,c) __builtin_fmaxf(__builtin_fmaxf((a),(b)),(c))
  #define GAPA(MF,A0,A1,A2,A3,W0,W1,PW) do{ MF; sacc+=A0; sacc+=A1; sacc+=A2; sacc+=A3; PIN(sacc); W0; W1; PIN(PW); SBAR(); }while(0)
  #define EX(v) __builtin_amdgcn_exp2f(v)
  #define GAPB(MF,X,B) do{ MF; X[B]=EX(X[B]); X[B+1]=EX(X[B+1]); X[B+2]=EX(X[B+2]); X[B+3]=EX(X[B+3]); PIN(X); SBAR(); }while(0)
  #define VRD(i) do{ vlo[i]=vtr(vp_+(((i)>>2)*4096+((i)&3)*1024)); vhi[i]=vtr(vp_+(((i)>>2)*4096+((i)&3)*1024+512)); }while(0)
  #define KRD(G,j) do{ if(G){ kload2(kf,kp0+sl_next,j); SBAR(); } }while(0)
  #define STEP(C0,C1,P0,P1,t,GK,GV,GL) do{ SBAR(); \
    const lds_cptr vp_=vp0+sl_prev; \
    VRD(0); SBAR(); float sacc=(P0[0]+P0[1]); \
    GAPA(C0=__builtin_amdgcn_mfma_f32_32x32x16_bf16(kf[0],qr[0],negm,0,0,0), P0[2],P0[3],P0[4],P0[5],     pw0[0]=PKW(P0,0), pw0[1]=PKW(P0,2), pw0); \
    VRD(4); SBAR(); GAPA(C1=__builtin_amdgcn_mfma_f32_32x32x16_bf16(kf[1],qr[0],negm,0,0,0), P0[6],P0[7],P0[8],P0[9],     pw0[2]=PKW(P0,4), pw0[3]=PKW(P0,6), pw0); \
    VRD(1); SBAR(); GAPA(C0=__builtin_amdgcn_mfma_f32_32x32x16_bf16(kf[2],qr[1],C0,0,0,0),   P0[10],P0[11],P0[12],P0[13], pw1[0]=PKW(P0,8), pw1[1]=PKW(P0,10), pw1); \
    VRD(5); SBAR(); GAPA(C1=__builtin_amdgcn_mfma_f32_32x32x16_bf16(kf[3],qr[1],C1,0,0,0),   P0[14],P0[15],P1[0],P1[1],   pw1[2]=PKW(P0,12),pw1[3]=PKW(P0,14), pw1); \
    VRD(2); SBAR(); GAPA(C0=__builtin_amdgcn_mfma_f32_32x32x16_bf16(kf[4],qr[2],C0,0,0,0),   P1[2],P1[3],P1[4],P1[5],     pw2[0]=PKW(P1,0), pw2[1]=PKW(P1,2), pw2); \
    VRD(6); SBAR(); GAPA(C1=__builtin_amdgcn_mfma_f32_32x32x16_bf16(kf[5],qr[2],C1,0,0,0),   P1[6],P1[7],P1[8],P1[9],     pw2[2]=PKW(P1,4), pw2[3]=PKW(P1,6), pw2); \
    VRD(3); SBAR(); GAPA(C0=__builtin_amdgcn_mfma_f32_32x32x16_bf16(kf[6],qr[3],C0,0,0,0),   P1[10],P1[11],P1[12],P1[13], pw3[0]=PKW(P1,8), pw3[1]=PKW(P1,10), pw3); \
    VRD(7); SBAR(); GAPA(C1=__builtin_amdgcn_mfma_f32_32x32x16_bf16(kf[7],qr[3],C1,0,0,0),   P1[14],P1[15],0.f,0.f,       pw3[2]=PKW(P1,12),pw3[3]=PKW(P1,14), pw3); \
    l_reg+=sacc; \
    if(GK){DMA_K((t)+3,sl_cur);} if(GV){DMA_V((t)+1,sl_next);} \
    CMASK(C0,C1,t); \
    { float a=MX3(C0[0],C0[1],C1[0]),b=MX3(C0[2],C0[3],C1[1]); a=MX3(a,C1[2],C1[3]); \
      _Pragma("unroll") for(int r=4;r<16;r+=4){a=MX3(a,C0[r],C0[r+1]);b=MX3(b,C0[r+2],C0[r+3]);a=MX3(a,C1[r],C1[r+1]);b=MX3(b,C1[r+2],C1[r+3]);} \
      float rm=__builtin_fmaxf(a,b); { auto rr=__builtin_amdgcn_permlane32_swap(__float_as_uint(rm),__float_as_uint(rm),false,false); rm=__builtin_fmaxf(__uint_as_float(rr[0]),__uint_as_float(rr[1])); } \
      resc=false; \
      if(__builtin_expect(__any(rm>(float)THRL),0)){ const float dl=__builtin_fmaxf(rm,0.f); mhat+=dl; \
        _Pragma("unroll") for(int r=0;r<16;++r){C0[r]-=dl;C1[r]-=dl;} \
        _Pragma("unroll") for(int r=0;r<16;++r)negm[r]=-mhat; asm volatile("":"+v"(negm)); \
        const float f=__builtin_amdgcn_exp2f(-dl); l_reg*=f; if(hi==0)wsf[r32]=f; resc=true; } } \
    SBAR(); \
    GAPB(o[0]=__builtin_amdgcn_mfma_f32_32x32x16_bf16(PAF(0),VFR(0),o[0],0,0,0), C0,0); \
    GAPB(o[1]=__builtin_amdgcn_mfma_f32_32x32x16_bf16(PAF(0),VFR(4),o[1],0,0,0), C0,4); \
    KRD(GL,0); GAPB(o[0]=__builtin_amdgcn_mfma_f32_32x32x16_bf16(PAF(1),VFR(1),o[0],0,0,0), C0,8); \
    KRD(GL,1); GAPB(o[1]=__builtin_amdgcn_mfma_f32_32x32x16_bf16(PAF(1),VFR(5),o[1],0,0,0), C0,12); \
    KRD(GL,2); GAPB(o[0]=__builtin_amdgcn_mfma_f32_32x32x16_bf16(PAF(2),VFR(2),o[0],0,0,0), C1,0); \
    KRD(GL,3); GAPB(o[1]=__builtin_amdgcn_mfma_f32_32x32x16_bf16(PAF(2),VFR(6),o[1],0,0,0), C1,4); \
    GAPB(o[0]=__builtin_amdgcn_mfma_f32_32x32x16_bf16(PAF(3),VFR(3),o[0],0,0,0), C1,8); \
    GAPB(o[1]=__builtin_amdgcn_mfma_f32_32x32x16_bf16(PAF(3),VFR(7),o[1],0,0,0), C1,12); \
    }while(0)
  int t=1;
  for(;t+5<NT;t+=2){
    MROT(); MLOAD(t+1); STEP(pB0,pB1,pA0,pA1,t,true,true,true);     WAIT_BAR(2); RESC(); ROT();
    MROT(); MLOAD(t+2); STEP(pA0,pA1,pB0,pB1,t+1,true,true,true);   WAIT_BAR(2); RESC(); ROT();
  }
  #define ENDW(tt) do{ if((tt)+3<NT){WAIT_BAR(2);} else if((tt)+2<NT){WAIT_BAR(1);} else {WAIT_BAR(0);} }while(0)
  for(;t+1<NT;t+=2){
    MROT(); MLOAD(t+1); STEP(pB0,pB1,pA0,pA1,t,(t+3<NT),(t+1<NT),(t+1<NT));       ENDW(t);   RESC(); ROT();
    MROT(); if(t+2<NT)MLOAD(t+2); STEP(pA0,pA1,pB0,pB1,t+1,(t+4<NT),(t+2<NT),(t+2<NT));     ENDW(t+1); RESC(); ROT();
  }
  MROT(); STEP(pB0,pB1,pA0,pA1,NT-1,false,false,false); RESC();
  { float sacc=pB0[0]+pB0[1]; _Pragma("unroll") for(int r=2;r<16;++r)sacc+=pB0[r]; _Pragma("unroll") for(int r=0;r<16;++r)sacc+=pB1[r]; l_reg+=sacc;
    pw0=(u32x4){PKW(pB0,0),PKW(pB0,2),PKW(pB0,4),PKW(pB0,6)};pw1=(u32x4){PKW(pB0,8),PKW(pB0,10),PKW(pB0,12),PKW(pB0,14)};pw2=(u32x4){PKW(pB1,0),PKW(pB1,2),PKW(pB1,4),PKW(pB1,6)};pw3=(u32x4){PKW(pB1,8),PKW(pB1,10),PKW(pB1,12),PKW(pB1,14)};
    SBAR(); pv(o,vb0+sl_cur,PAF(0),PAF(1),PAF(2),PAF(3)); }
  #undef PKW
  #undef PAF
  #undef VFR
  #undef PIN
  #undef MX3
  #undef GAPA
  #undef GAPB
  #undef EX
  #undef VRD
  #undef KRD
  #undef STEP
  #undef ENDW
  {auto rr=__builtin_amdgcn_permlane32_swap(__float_as_uint(l_reg),__float_as_uint(l_reg),false,false);l_reg=__uint_as_float(rr[0])+__uint_as_float(rr[1]);}
  if(hi==0)wsf[32+r32]=l_reg;asm volatile("s_waitcnt lgkmcnt(0)":::"memory");
  float rli[16];
  #pragma unroll
  for(int r=0;r<16;++r)rli[r]=__builtin_amdgcn_rcpf(wsf[32+crow(r,hi)]);
  if(MODE==MODE_DIL){ if(hi==0) ds.lse[(long)qrel*ds.lses]=mhat+__builtin_amdgcn_logf(l_reg); }
  bf16*Ow=ds.O+(long)(wid*QBLK)*OS;
  { bf16*stg=(bf16*)(shm+LDS_OST)+wid*2048;
    #pragma unroll
    for(int r=0;r<16;++r){const int orow=crow(r,hi);
      #pragma unroll
      for(int d0=0;d0<2;++d0)stg[orow*64+d0*32+r32]=__float2bfloat16(o[d0][r]*rli[r]);}
    asm volatile("s_waitcnt lgkmcnt(0)":::"memory");
    #pragma unroll
    for(int i=0;i<4;++i){const int row=i*8+(lane>>3),ch=lane&7; const u32x4 v=*(const u32x4*)(stg+row*64+ch*8); ATTN_STORE16(Ow+(long)row*OS+ch*8,v);} }
  asm volatile("s_waitcnt lgkmcnt(0)\n\ts_barrier":::"memory");
  #undef DMA_K
  #undef DMA_V
  #undef CMASK
  #undef MLOAD
  #undef MROT
  #undef START
  #undef RESC
  #undef ROT
}
constexpr int ATTN_LDS_BYTES=LDS_BYTES;
#undef SBAR
#undef WAIT_BAR
}
namespace idx {
typedef short bf16x8 __attribute__((ext_vector_type(8)));
typedef float f32x16 __attribute__((ext_vector_type(16)));
typedef float f32x4 __attribute__((ext_vector_type(4)));
typedef unsigned u32x4 __attribute__((ext_vector_type(4)));
#define IDX_LAS __attribute__((address_space(3)))
constexpr int TOPK = 256;
__device__ __forceinline__ unsigned key16(float s) {
    const _Float16 h = (_Float16)s; unsigned u = __builtin_bit_cast(unsigned short, h);
    if (u == 0x8000u) u = 0u;
    return (u & 0x8000u) ? (~u & 0xffffu) : (u | 0x8000u);
}
__device__ __forceinline__ int wave_sum_i32(int v) {
    v += __builtin_amdgcn_update_dpp(0, v, 0x111, 0xf, 0xf, false);
    v += __builtin_amdgcn_update_dpp(0, v, 0x112, 0xf, 0xf, false);
    v += __builtin_amdgcn_update_dpp(0, v, 0x114, 0xf, 0xf, false);
    v += __builtin_amdgcn_update_dpp(0, v, 0x118, 0xf, 0xf, false);
    v += __builtin_amdgcn_update_dpp(0, v, 0x142, 0xa, 0xf, false);
    v += __builtin_amdgcn_update_dpp(0, v, 0x143, 0xc, 0xf, false);
    return __builtin_amdgcn_readlane(v, 63);
}
#define IDX_COUNT_GE(res, thr) do { int c_ = 0; \
    _Pragma("unroll") for (int ch_ = 0; ch_ < 8; ++ch_) { if (8 * ch_ < nrow) { _Pragma("unroll") for (int jj_ = 0; jj_ < 8; ++jj_) c_ += (kv[8 * ch_ + jj_] >= (thr)) ? 1 : 0; } } \
    res = wave_sum_i32(c_); } while (0)

__device__ __forceinline__ void indexer_unit(int b, int q0, const unsigned short* QI, const unsigned short* KI, const float* WI, unsigned* SELT, IDX_LAS unsigned char* lds) {
    const int tid = threadIdx.x, lane = tid & 63, r32 = lane & 31, hi = lane >> 5; const int wid = __builtin_amdgcn_readfirstlane(tid >> 6);
    IDX_LAS unsigned short* SC = (IDX_LAS unsigned short*)lds;
    IDX_LAS unsigned* MS = (IDX_LAS unsigned*)(lds + 131072);
    const long rowb = (long)b * 4096;
    bf16x8 qa[4][4]; f32x4 wv[4][4];
#pragma unroll
    for (int rb = 0; rb < 4; ++rb)
#pragma unroll
        for (int ks = 0; ks < 4; ++ks) qa[rb][ks] = *(const bf16x8*)(QI + (rowb + q0 + 4 * rb + (r32 >> 3)) * 512 + (r32 & 7) * 64 + 16 * ks + 8 * hi);
#pragma unroll
    for (int rb = 0; rb < 4; ++rb)
#pragma unroll
        for (int ql = 0; ql < 4; ++ql) wv[rb][ql] = *(const f32x4*)(WI + (rowb + q0 + 4 * rb + ql) * 8 + 4 * hi);
    const int nkt = ((q0 >> 5) + 2) & ~1;
    for (int kt = wid; kt < nkt; kt += 8) {
        bf16x8 kb[4];
#pragma unroll
        for (int ks = 0; ks < 4; ++ks) kb[ks] = *(const bf16x8*)(KI + (rowb + 32 * kt + r32) * 64 + 16 * ks + 8 * hi);
        const int key = 32 * kt + r32;
#pragma unroll
        for (int rb = 0; rb < 4; ++rb) {
            f32x16 c = {};
#pragma unroll
            for (int ks = 0; ks < 4; ++ks) c = __builtin_amdgcn_mfma_f32_32x32x16_bf16(qa[rb][ks], kb[ks], c, 0, 0, 0);
            float sp[4];
#pragma unroll
            for (int ql = 0; ql < 4; ++ql) {
                float s = wv[rb][ql][0] * fmaxf(c[4 * ql + 0], 0.f);
                s += wv[rb][ql][1] * fmaxf(c[4 * ql + 1], 0.f); s += wv[rb][ql][2] * fmaxf(c[4 * ql + 2], 0.f); s += wv[rb][ql][3] * fmaxf(c[4 * ql + 3], 0.f);
                sp[ql] = s;
            }
#pragma unroll
            for (int e = 0; e < 2; ++e) {
                const auto rr = __builtin_amdgcn_permlane32_swap(__float_as_uint(sp[e]), __float_as_uint(sp[2 + e]), false, false);
                const float v = __uint_as_float(rr[0]) + __uint_as_float(rr[1]); const int qi = 4 * rb + 2 * hi + e;
                SC[qi * 4096 + key] = (unsigned short)((key <= q0 + qi) ? key16(v) : 0u);
            }
        }
    }
    __syncthreads();
    const int nrow = nkt >> 1;
#pragma unroll 1
    for (int e = 0; e < 2; ++e) {
        const int qi = 2 * wid + e, t = q0 + qi;
        unsigned kv[64];
#pragma unroll
        for (int ch = 0; ch < 8; ++ch) {
            if (8 * ch < nrow) {
#pragma unroll
                for (int jj = 0; jj < 8; ++jj) { const int j = 8 * ch + jj; kv[j] = (j < nrow) ? (unsigned)SC[qi * 4096 + 64 * j + lane] : 0u; }
            } else {
#pragma unroll
                for (int jj = 0; jj < 8; ++jj) kv[8 * ch + jj] = 0u;
            }
        }
        unsigned T = 1u; int cntT = t + 1; bool tie = false; int need = 0;
        if (t + 1 > TOPK) {
            T = 0u;
#pragma unroll 1
            for (int bit = 15; bit >= 0; --bit) {
                const unsigned cand = T | (1u << bit); int c; IDX_COUNT_GE(c, cand);
                if (c >= TOPK) { T = cand; cntT = c; }
            }
            if (cntT > TOPK) { tie = true; int ngt; IDX_COUNT_GE(ngt, T + 1u); need = TOPK - ngt; }
        }
        unsigned vlo = 0u, vhi = 0u;
#pragma unroll
        for (int j = 0; j < 64; ++j) {
            if (j < nrow) {
                unsigned long long m;
                if (!tie) m = __ballot(kv[j] >= T);
                else {
                    const bool iseq = kv[j] == T; const unsigned long long eq = __ballot(iseq), gt = __ballot(kv[j] > T);
                    const int rank = (int)__builtin_amdgcn_mbcnt_hi((unsigned)(eq >> 32), __builtin_amdgcn_mbcnt_lo((unsigned)eq, 0u));
                    const unsigned long long take = __ballot(iseq && rank < need);
                    need -= __popcll(take); m = gt | take;
                }
                const unsigned lo = (unsigned)m, hw = (unsigned)(m >> 32);
                if (j < 32) { vlo = (lane == 2 * j) ? lo : vlo; vlo = (lane == 2 * j + 1) ? hw : vlo; }
                else { vhi = (lane == 2 * j - 64) ? lo : vhi; vhi = (lane == 2 * j - 63) ? hw : vhi; }
            }
        }
        MS[lane * 16 + qi] = vlo; MS[(64 + lane) * 16 + qi] = vhi;
    }
    __syncthreads();
    { const int w = tid >> 2, qq = (tid & 3) * 4; const u32x4 v = *(const IDX_LAS u32x4*)(MS + w * 16 + qq);
      *(u32x4*)(SELT + ((size_t)b * 128 + w) * 4096 + q0 + qq) = v; }
    __syncthreads();
}
#undef IDX_COUNT_GE
}
constexpr int NB = 8, SEQ = 4096, DM = 1024, MTOK = NB * SEQ;
constexpr int MEMT = 256, MROWS = NB * MEMT;
constexpr int DFF = 2816, A_IN = 2120, A_INP = 2304, B_IN = 2560;
constexpr int NWAVES = 8;
constexpr size_t MiB = 1u << 20;
constexpr size_t WS_CTL = 0, CTL_ZERO_BYTES = 1 * MiB;
constexpr size_t WS_WIN0 = 2 * MiB, WS_WMKV0 = 7 * MiB, WS_WO0 = 8 * MiB, WS_WGU0 = 10 * MiB, WS_WD0 = 21 * MiB;
constexpr size_t WS_WIN1 = 27 * MiB, WS_WMKV1 = 32 * MiB, WS_WO1 = 33 * MiB, WS_WGU1 = 34 * MiB, WS_WD1 = 45 * MiB;
constexpr size_t WS_CS = 51 * MiB, WS_SN = 55 * MiB, WS_SS = 59 * MiB, WS_SSM = 61 * MiB, WS_MB = 62 * MiB, WS_MKV0 = 66 * MiB, WS_MKV1 = 68 * MiB;
constexpr size_t WS_XS = 70 * MiB;
constexpr size_t WS_R = 134 * MiB;
constexpr size_t WS_Q0 = WS_R, WS_K0 = WS_R + 48 * MiB, WS_V0 = WS_R + 64 * MiB, WS_QI = WS_R + 80 * MiB, WS_KI = WS_R + 112 * MiB, WS_WI = WS_R + 116 * MiB, WS_QM = WS_R + 117 * MiB;
constexpr size_t WS_SEL = WS_R + 133 * MiB, WS_O0 = WS_R + 149 * MiB;
constexpr size_t WS_H = WS_R;
constexpr size_t WS_P1 = WS_R, WS_OG = WS_R + 160 * MiB, WS_LSE = WS_R + 208 * MiB, WS_O1 = WS_R + 210 * MiB;
constexpr size_t WS_END = WS_R + 242 * MiB;
static_assert(WS_O0 + (size_t)MTOK * 1024 * 2 <= WS_END && WS_H + (size_t)MTOK * DFF * 2 <= WS_O1 && WS_END <= 512 * MiB, "d_ws map");
constexpr int CW_BAR = 4096;
constexpr int RING_OFF = 0, RING_BYTES = 131072;
constexpr int LDSCTL_OFF = 160 * 1024 - 512, MISC_OFF = LDSCTL_OFF + 320;
constexpr int LDS_BYTES = 160 * 1024;

#define GAS __attribute__((address_space(1)))
#define LAS __attribute__((address_space(3)))
typedef unsigned short bf16;
typedef unsigned v4u __attribute__((ext_vector_type(4)));
typedef float f32x4 __attribute__((ext_vector_type(4)));
typedef short bf16x8 __attribute__((ext_vector_type(8)));
typedef GAS unsigned gu32;
typedef GAS unsigned long long gu64;
#define RLX_AGENT __ATOMIC_RELAXED, __HIP_MEMORY_SCOPE_AGENT
#define LDS_WAIT() asm volatile("s_waitcnt lgkmcnt(0)" ::: "memory")
#define VM_WAIT() asm volatile("s_waitcnt vmcnt(0)" ::: "memory")
__device__ __forceinline__ unsigned long long rt() { return __builtin_amdgcn_s_memrealtime(); }
__device__ __forceinline__ unsigned f2bf(float f) { unsigned u = __builtin_bit_cast(unsigned, f); return (u + 0x7fffu + ((u >> 16) & 1u)) >> 16; }
__device__ __forceinline__ unsigned pk2(float lo, float hi) { return f2bf(lo) | (f2bf(hi) << 16); }

#define XB_TMO      128
#define XB_XCNT(j)  (256  + 64 * (j))
#define XB_XSUB(j)  (1280 + 64 * (j))
#define XB_XGEN(j)  (2304 + 64 * (j))
#define XB_TOP      3328
#define XB_TOPGEN   3392
#define XCD_BAR_WORDS 3456
#define XB_SPIN_CAP (1u << 18)

__device__ __forceinline__ unsigned xb_ld(unsigned* p)              { return __hip_atomic_load(p, __ATOMIC_RELAXED, __HIP_MEMORY_SCOPE_AGENT); }
__device__ __forceinline__ unsigned xb_add(unsigned* p, unsigned v) { return __hip_atomic_fetch_add(p, v, __ATOMIC_RELAXED, __HIP_MEMORY_SCOPE_AGENT); }
__device__ __forceinline__ unsigned xb_xcc_id() { return (unsigned)__builtin_amdgcn_s_getreg((3 << 11) | 20) & 0xFu; }
#define XB_SPIN(cond, bar) do { unsigned _sp = 0; while (cond) { __builtin_amdgcn_s_sleep(1); \
    if ((++_sp & 255u) == 0u) { if (xb_ld(&(bar)[XB_TMO])) break; if (_sp > XB_SPIN_CAP) { atomicAdd(&(bar)[XB_TMO], 1u); break; } } } } while (0)

struct XcdBarrier {
    unsigned* bar; unsigned x;
    volatile LAS unsigned* st;
};

__device__ __forceinline__ XcdBarrier xcd_barrier_post(unsigned* bar, volatile LAS unsigned* st) {
    XcdBarrier b; b.bar = bar; b.x = xb_xcc_id(); b.st = st;
    if (threadIdx.x == 0) (void)xb_add(&bar[XB_XCNT(b.x)], 1u);
    return b;
}
__device__ __forceinline__ void xcd_barrier_complete(unsigned* bar, unsigned x, unsigned& nloc, unsigned& nx) {
    const unsigned G = gridDim.x * gridDim.y * gridDim.z;
    unsigned sum, cnt, mine, sp = 0u;
    for (;;) {
        sum = 0u; cnt = 0u; mine = 0u;
#pragma unroll
        for (unsigned j = 0; j < 16; ++j) { const unsigned c = xb_ld(&bar[XB_XCNT(j)]); sum += c; cnt += (c > 0u) ? 1u : 0u; mine = (j == x) ? c : mine; }
        if (sum == G) break;
        __builtin_amdgcn_s_sleep(1);
        if ((++sp & 255u) == 0u) { if (xb_ld(&bar[XB_TMO])) break; if (sp > XB_SPIN_CAP) { atomicAdd(&bar[XB_TMO], 1u); break; } }
    }
    nloc = mine > 0u ? mine : 1u; nx = cnt > 0u ? cnt : 1u;
}

__device__ __forceinline__ void xcd_barrier(const XcdBarrier& b) {
    asm volatile("s_waitcnt vmcnt(0)" ::: "memory");
    __syncthreads();
    if (threadIdx.x == 0) {
        unsigned* bar = b.bar;
        __builtin_amdgcn_s_waitcnt(0);
        unsigned nloc = b.st[0], nx = b.st[1];
        if (nloc == 0u) { xcd_barrier_complete(bar, b.x, nloc, nx); b.st[0] = nloc; b.st[1] = nx; }
        const unsigned old = xb_add(&bar[XB_XSUB(b.x)], 1u);
        const unsigned gen = old / nloc;
        if (old + 1u == (gen + 1u) * nloc) {
            __builtin_amdgcn_fence(__ATOMIC_RELEASE, "agent");
            asm volatile("s_waitcnt vmcnt(0)" ::: "memory");
            const unsigned og = xb_add(&bar[XB_TOP], 1u);
            const unsigned tg = og / nx;
            if (og + 1u == (tg + 1u) * nx) xb_add(&bar[XB_TOPGEN], 1u);
            else XB_SPIN(xb_ld(&bar[XB_TOPGEN]) == tg, bar);
            __builtin_amdgcn_fence(__ATOMIC_ACQUIRE, "agent");
            xb_add(&bar[XB_XGEN(b.x)], 1u);
            asm volatile("s_waitcnt vmcnt(0)" ::: "memory");
        } else {
            XB_SPIN(xb_ld(&bar[XB_XGEN(b.x)]) == gen, bar);
            __builtin_amdgcn_fence(__ATOMIC_ACQUIRE, "agent");
            asm volatile("s_waitcnt vmcnt(0)" ::: "memory");
        }
    }
    __syncthreads();
}

struct Frame {
    LAS unsigned char* lds;
    volatile LAS unsigned* MISC;
    gu32* ctl;
    int tid, lane, wave, vcu, G;
};
__device__ __forceinline__ float wave_sum(float v) {
#pragma unroll
    for (int o = 1; o < 64; o <<= 1) v += __shfl_xor(v, o);
    return v;
}
enum { T_PLAIN = 0, T_WIN0 = 1, T_WIN1 = 2, T_GU = 3 };
__device__ __forceinline__ int srcmap(int type, int rho, int N, int& nvalid) {
    nvalid = 16;
    const int pn = rho >> 8, w = rho & 255;
    const int permw = (w & 0xC0) | (((w >> 5) & 1) << 4) | (((w >> 4) & 1) << 5);
    if (type == T_PLAIN) { if (rho >= N) nvalid = 0; return rho; }
    if (type == T_WIN0) {
        if (pn < 3) return pn * 256 + permw;
        if (pn == 3) return 768 + permw;
        if (pn == 4) return 1024 + w;
        if (pn < 7) return 1280 + (pn - 5) * 256 + w;
        if (pn == 7) return 1864 + w;
        if (w < 64) return 1792 + w;
        if (w == 64) { nvalid = 8; return 1856; }
        nvalid = 0; return 0;
    }
    if (type == T_WIN1) { const bool rope = (pn < 9) && (pn % 3 != 2); return pn * 256 + (rope ? permw : w); }
    return (w < 128) ? (pn * 128 + w) : (DFF + pn * 128 + (w - 128));
}
__device__ __forceinline__ void p0_transpose_item(const float* W, const float* gain, int K, int N, int type, bf16* WT, LAS float* scr, int item, int lane) {
    const int nblk_shift = 0; (void)nblk_shift;
    const int Nd_blocks = (type == T_WIN0 ? A_INP : (type == T_GU ? 2 * DFF : N)) / 32;
    const int kb = item / Nd_blocks, nb = item % Nd_blocks, k0 = 64 * kb, n0 = 32 * nb;
    int nv; const int half = (lane >> 4) & 1;
    const int sc0 = srcmap(type, n0 + 16 * half, N, nv);
    const int j = lane & 15; const bool ok = j < nv; const int sc = sc0 + j;
#pragma unroll 8
    for (int i = 0; i < 32; ++i) { const int kk = 2 * i + (lane >> 5);
        float v = 0.f; if (ok) { v = W[(size_t)(k0 + kk) * N + sc]; if (gain) v *= gain[k0 + kk]; }
        scr[kk * 33 + (lane & 31)] = v; }
    LDS_WAIT(); asm volatile("" ::: "memory");
    const int c = lane & 7;
#pragma unroll
    for (int jj = 0; jj < 4; ++jj) { const int n = (lane >> 3) + 8 * jj; const LAS float* s = scr + (8 * c) * 33 + n;
        v4u o; o.x = pk2(s[0 * 33], s[1 * 33]); o.y = pk2(s[2 * 33], s[3 * 33]); o.z = pk2(s[4 * 33], s[5 * 33]); o.w = pk2(s[6 * 33], s[7 * 33]);
        *(GAS v4u*)(WT + (size_t)(n0 + n) * K + k0 + 8 * c) = o; }
    LDS_WAIT(); asm volatile("" ::: "memory");
}
__device__ __forceinline__ void row_to_bf16(int lane, const float* xrow, bf16* orow, float* ssrow) {
    const GAS f32x4* xr = (const GAS f32x4*)xrow + lane;
    f32x4 v[4]; float s = 0.f;
#pragma unroll
    for (int j = 0; j < 4; ++j) { v[j] = xr[64 * j]; s += (v[j].x * v[j].x + v[j].y * v[j].y) + (v[j].z * v[j].z + v[j].w * v[j].w); }
    s = wave_sum(s);
    GAS unsigned long long* o8 = (GAS unsigned long long*)orow + lane;
#pragma unroll
    for (int j = 0; j < 4; ++j) o8[64 * j] = (unsigned long long)pk2(v[j].x, v[j].y) | ((unsigned long long)pk2(v[j].z, v[j].w) << 32);
    if (lane < 16) ssrow[lane] = (lane == 0) ? s : 0.f;
}
__device__ __forceinline__ void sincos_acc(float af, float& sn, float& cs) {
    const double a = (double)af; const double k = __builtin_rint(a * 0.63661977236758134308);
    double r = __builtin_fma(-k, 1.57079632679489655800e+00, a); r = __builtin_fma(-k, 6.12323399573676603587e-17, r);
    const double r2 = r * r;
    const double sp = r + r * r2 * (-1.0 / 6 + r2 * (1.0 / 120 + r2 * (-1.0 / 5040 + r2 * (1.0 / 362880 + r2 * (-1.0 / 39916800 + r2 * (1.0 / 6227020800.0))))));
    const double cp = 1.0 + r2 * (-0.5 + r2 * (1.0 / 24 + r2 * (-1.0 / 720 + r2 * (1.0 / 40320 + r2 * (-1.0 / 3628800 + r2 * (1.0 / 479001600.0))))));
    const int q = ((int)k) & 3;
    const double s = (q == 0) ? sp : (q == 1) ? cp : (q == 2) ? -sp : -cp;
    const double c = (q == 0) ? cp : (q == 1) ? -sp : (q == 2) ? -cp : sp;
    sn = (float)s; cs = (float)c;
}
struct Args { const float* in[20]; float* out; unsigned char* ws; int ph_lo, ph_hi, li, pad; };

__device__ __forceinline__ void p0_prologue(Frame& F, const Args& args) {
    LAS float* scr = (LAS float*)(F.lds + RING_OFF + F.wave * 16384);
    const int gw = F.vcu * NWAVES + F.wave, NGW = F.G * NWAVES;
    unsigned char* ws = args.ws;
    {
        constexpr int I_IN0 = 16 * (A_INP / 32), I_MKV = 16 * 16, I_O0 = 16 * 32, I_GU = 16 * (2 * DFF / 32), I_D = (DFF / 64) * 32, I_IN1 = 16 * (B_IN / 32), I_O1 = 8 * 32;
        constexpr int NITEMS = I_IN0 + I_MKV + I_O0 + I_GU + I_D + I_IN1 + I_MKV + I_O1 + I_GU + I_D;
        for (int it = gw; it < NITEMS; it += NGW) {
            int r = it;
            if (r < I_IN0) { p0_transpose_item(args.in[5], args.in[3], DM, A_IN, T_WIN0, (bf16*)(ws + WS_WIN0), scr, r, F.lane); continue; } r -= I_IN0;
            if (r < I_MKV) { p0_transpose_item(args.in[6], args.in[4], DM, 512, T_PLAIN, (bf16*)(ws + WS_WMKV0), scr, r, F.lane); continue; } r -= I_MKV;
            if (r < I_O0) { p0_transpose_item(args.in[7], nullptr, DM, DM, T_PLAIN, (bf16*)(ws + WS_WO0), scr, r, F.lane); continue; } r -= I_O0;
            if (r < I_GU) { p0_transpose_item(args.in[9], args.in[8], DM, 2 * DFF, T_GU, (bf16*)(ws + WS_WGU0), scr, r, F.lane); continue; } r -= I_GU;
            if (r < I_D) { p0_transpose_item(args.in[10], nullptr, DFF, DM, T_PLAIN, (bf16*)(ws + WS_WD0), scr, r, F.lane); continue; } r -= I_D;
            if (r < I_IN1) { p0_transpose_item(args.in[13], args.in[11], DM, B_IN, T_WIN1, (bf16*)(ws + WS_WIN1), scr, r, F.lane); continue; } r -= I_IN1;
            if (r < I_MKV) { p0_transpose_item(args.in[14], args.in[12], DM, 512, T_PLAIN, (bf16*)(ws + WS_WMKV1), scr, r, F.lane); continue; } r -= I_MKV;
            if (r < I_O1) { p0_transpose_item(args.in[15], nullptr, 512, DM, T_PLAIN, (bf16*)(ws + WS_WO1), scr, r, F.lane); continue; } r -= I_O1;
            if (r < I_GU) { p0_transpose_item(args.in[17], args.in[16], DM, 2 * DFF, T_GU, (bf16*)(ws + WS_WGU1), scr, r, F.lane); continue; } r -= I_GU;
            p0_transpose_item(args.in[18], nullptr, DFF, DM, T_PLAIN, (bf16*)(ws + WS_WD1), scr, r, F.lane);
        }
    }
    for (int m = gw; m < MTOK; m += NGW) row_to_bf16(F.lane, args.in[0] + (size_t)m * DM, (bf16*)(ws + WS_XS) + (size_t)m * DM, (float*)(ws + WS_SS) + (size_t)m * 16);
    for (int m = gw; m < MROWS; m += NGW) row_to_bf16(F.lane, args.in[1] + (size_t)m * DM, (bf16*)(ws + WS_MB) + (size_t)m * DM, (float*)(ws + WS_SSM) + (size_t)m * 16);
    {
        const int* pos = (const int*)args.in[2]; float* CS = (float*)(ws + WS_CS); float* SN = (float*)(ws + WS_SN);
        const int gt = F.vcu * (NWAVES * 64) + F.tid, NGT = F.G * NWAVES * 64;
        for (int e = gt; e < MTOK * 32; e += NGT) { const int row = e >> 5, i = e & 31;
            const float freq = powf(10000.0f, -(float)i * (1.0f / 32.0f)); const float ang = (float)pos[row] * freq;
            float s, c; sincos_acc(ang, s, c); CS[e] = c; SN[e] = s; }
    }
}
__device__ __forceinline__ void final_norm_phase(Frame& F, const Args& args) {
    const int gw = F.vcu * NWAVES + F.wave, NGW = F.G * NWAVES;
    const float* ss = (const float*)(args.ws + WS_SS); const GAS f32x4* g4 = (const GAS f32x4*)args.in[19] + F.lane;
    for (int m = gw; m < MTOK; m += NGW) {
        const float rs = pg8::rstd_of(ss, m);
        GAS f32x4* o = (GAS f32x4*)(args.out + (size_t)m * DM) + F.lane;
#pragma unroll
        for (int j = 0; j < 4; ++j) { const f32x4 v = o[64 * j], g = g4[64 * j]; o[64 * j] = v * rs * g; }
    }
}


__device__ __forceinline__ void zero_cols(Frame& F, bf16* base, int pitch, int ncols) {
    const int gw = F.vcu * NWAVES + F.wave, NGW = F.G * NWAVES;
    for (int m = gw; m < MTOK; m += NGW) for (int c = 4 * F.lane; c < ncols; c += 256) *(GAS unsigned long long*)(base + (size_t)m * pitch + c) = 0ull;
}

__device__ __forceinline__ void indexer_phase(Frame& F, unsigned char* ws) {
    for (int i = 0; i < 4; ++i) {
        const int p = 4 * F.vcu + i; if (p >= 1024) break;
        const int b = p >> 7, blk = p & 127;
        idx::indexer_unit(b, 16 * (255 - blk), (const unsigned short*)(ws + WS_QI), (const unsigned short*)(ws + WS_KI), (const float*)(ws + WS_WI), (unsigned*)(ws + WS_SEL), F.lds);
        idx::indexer_unit(b, 16 * blk, (const unsigned short*)(ws + WS_QI), (const unsigned short*)(ws + WS_KI), (const float*)(ws + WS_WI), (unsigned*)(ws + WS_SEL), F.lds);
    }
}
typedef __hip_bfloat16 hb16;
__device__ __forceinline__ void mem_attn_phase(Frame& F, unsigned char* ws, int layer, char* ldsp) {
    for (int i = 0; i < 2; ++i) {
        const int u = F.vcu + i * F.G; if (u >= 512) break;
        const int qb = u & 15, j = (u >> 4) & 3, b = u >> 6;
        attn_body::AttnDesc d{};
        const long row0 = (long)b * SEQ + 256 * qb;
        if (layer == 0) { d.Q = (const hb16*)(ws + WS_QM) + row0 * 256 + j * 64; d.qs = 256; d.O = (hb16*)(ws + WS_O0) + row0 * 1024 + 768 + j * 64; d.os = 1024; d.K = (const hb16*)(ws + WS_MKV0) + (long)b * MEMT * 512 + j * 64; }
        else { d.Q = (const hb16*)(ws + WS_P1) + row0 * 2560 + 2304 + j * 64; d.qs = 2560; d.O = (hb16*)(ws + WS_O1) + row0 * 512 + 256 + j * 64; d.os = 512; d.K = (const hb16*)(ws + WS_MKV1) + (long)b * MEMT * 512 + j * 64; }
        d.V = d.K + 256; d.ks = 512; d.NT = 4;
        attn_body::attn_unit<attn_body::MODE_MEM, 8>(d, ldsp);
    }
}
__device__ __forceinline__ void dsa_attn_phase(Frame& F, unsigned char* ws, char* ldsp) {
    for (int i = 0; i < 6; ++i) {
        const int p = 3 * F.vcu + (i >> 1); if (p >= 768) break;
        const int bh = p >> 3, s = p & 7, qb = (i & 1) ? s : 15 - s, b = bh / 12, h = bh % 12;
        attn_body::AttnDesc d{};
        const long row0 = (long)b * SEQ + 256 * qb;
        d.Q = (const hb16*)(ws + WS_Q0) + row0 * 768 + h * 64; d.qs = 768;
        d.K = (const hb16*)(ws + WS_K0) + (long)b * SEQ * 256 + (h / 3) * 64; d.V = (const hb16*)(ws + WS_V0) + (long)b * SEQ * 256 + (h / 3) * 64; d.ks = 256;
        d.O = (hb16*)(ws + WS_O0) + row0 * 1024 + h * 64; d.os = 1024; d.NT = 4 * (qb + 1);
        d.msk = (const unsigned*)(ws + WS_SEL) + (size_t)b * 128 * SEQ + 256 * qb;
        attn_body::attn_unit<attn_body::MODE_DSA, 8>(d, ldsp);
    }
}
__device__ __forceinline__ void dil_attn_phase(Frame& F, unsigned char* ws, char* ldsp) {
    for (int i = 0; i < 6; ++i) {
        const int u = 6 * F.vcu + i; if (u >= 1536) break;
        const int b = u / 192, rem = u % 192, j = rem / 48, s = rem % 48;
        int g, r, qb; if (s < 16) { g = 0; r = 0; qb = s; } else if (s < 32) { g = 1; r = (s - 16) >> 2; qb = (s - 16) & 3; } else { g = 2; r = s - 32; qb = 0; }
        const int dil = (g == 0) ? 1 : (g == 1) ? 4 : 16;
        const int k0 = (qb == 0) ? 0 : 256 * qb - 128;
        attn_body::AttnDesc d{};
        const long qrow = (long)b * SEQ + r + (long)dil * 256 * qb, krow = (long)b * SEQ + r + (long)dil * k0;
        const hb16* P1 = (const hb16*)(ws + WS_P1);
        d.Q = P1 + qrow * 2560 + (3 * g) * 256 + j * 64; d.qs = (long)dil * 2560;
        d.K = P1 + krow * 2560 + (3 * g + 1) * 256 + j * 64; d.V = P1 + krow * 2560 + (3 * g + 2) * 256 + j * 64; d.ks = (long)dil * 2560;
        d.O = (hb16*)(ws + WS_OG) + qrow * 768 + g * 256 + j * 64; d.os = (long)dil * 768; d.NT = (qb == 0) ? 4 : 6; d.dq0 = 256 * qb - k0;
        d.lse = (float*)(ws + WS_LSE) + qrow * 12 + g * 4 + j; d.lses = (long)dil * 12;
        attn_body::attn_unit<attn_body::MODE_DIL, 8>(d, ldsp);
    }
}
__device__ __forceinline__ void merge_phase(Frame& F, unsigned char* ws) {
    const int gw = F.vcu * NWAVES + F.wave, NGW = F.G * NWAVES, lane = F.lane, j = lane >> 4;
    const float* LSE = (const float*)(ws + WS_LSE); const bf16* OG = (const bf16*)(ws + WS_OG); bf16* O1 = (bf16*)(ws + WS_O1);
    for (int m = gw; m < MTOK; m += NGW) {
        const float l0 = LSE[(size_t)m * 12 + j], l1 = LSE[(size_t)m * 12 + 4 + j], l2 = LSE[(size_t)m * 12 + 8 + j];
        const float mx = fmaxf(l0, fmaxf(l1, l2));
        const float e0 = __builtin_amdgcn_exp2f(l0 - mx), e1 = __builtin_amdgcn_exp2f(l1 - mx), e2 = __builtin_amdgcn_exp2f(l2 - mx);
        const float inv = 1.0f / (e0 + e1 + e2);
        const unsigned long long a = *(const GAS unsigned long long*)(OG + (size_t)m * 768 + 4 * lane), bq = *(const GAS unsigned long long*)(OG + (size_t)m * 768 + 256 + 4 * lane), c = *(const GAS unsigned long long*)(OG + (size_t)m * 768 + 512 + 4 * lane);
        const unsigned a0 = (unsigned)a, a1 = (unsigned)(a >> 32), b0 = (unsigned)bq, b1 = (unsigned)(bq >> 32), c0 = (unsigned)c, c1 = (unsigned)(c >> 32);
        const float w0 = e0 * inv, w1 = e1 * inv, w2 = e2 * inv;
        const float r0 = w0 * pg8::bf_lo(a0) + w1 * pg8::bf_lo(b0) + w2 * pg8::bf_lo(c0), r1 = w0 * pg8::bf_hi(a0) + w1 * pg8::bf_hi(b0) + w2 * pg8::bf_hi(c0);
        const float r2 = w0 * pg8::bf_lo(a1) + w1 * pg8::bf_lo(b1) + w2 * pg8::bf_lo(c1), r3 = w0 * pg8::bf_hi(a1) + w1 * pg8::bf_hi(b1) + w2 * pg8::bf_hi(c1);
        *(GAS unsigned long long*)(O1 + (size_t)m * 512 + 4 * lane) = (unsigned long long)pk2(r0, r1) | ((unsigned long long)pk2(r2, r3) << 32);
    }
}

#ifndef MK_DSA
#define MK_DSA 1
#endif
#ifndef MK_DIL
#define MK_DIL 1
#endif
#ifndef MK_PHASE_MASK
#define MK_PHASE_MASK 0x3fff
#endif
constexpr int N_PHASES = 14;
#ifndef MK_N_LAUNCHES
#define MK_N_LAUNCHES N_PHASES
#endif

__global__ void __launch_bounds__(NWAVES * 64, 2) mk_fwd(Args args) {
    extern __shared__ __attribute__((aligned(16))) unsigned char lds[];
    Frame F;
    F.lds = (LAS unsigned char*)lds;
    F.MISC = (volatile LAS unsigned*)(F.lds + MISC_OFF);
    F.tid = threadIdx.x; F.lane = F.tid & 63; F.wave = __builtin_amdgcn_readfirstlane(F.tid >> 6);
    F.G = gridDim.x; { const int bx = blockIdx.x; F.vcu = (F.G % 8 == 0) ? (bx % 8) * (F.G / 8) + bx / 8 : bx; }
    unsigned char* ws = args.ws;
    F.ctl = (gu32*)(ws + WS_CTL);
    for (int u = F.tid; u < (LDS_BYTES - LDSCTL_OFF) / 4; u += NWAVES * 64) ((LAS unsigned*)(F.lds + LDSCTL_OFF))[u] = 0u;
    __syncthreads();
    XcdBarrier bar; bar.bar = (unsigned*)(F.ctl + CW_BAR); bar.x = 0; bar.st = nullptr;
    if (MK_N_LAUNCHES == 1) bar = xcd_barrier_post((unsigned*)(F.ctl + CW_BAR), F.MISC + 8);
    const int lo = args.ph_lo, hi = args.ph_hi;
#define IN(k) (lo <= (k) && (k) < hi && ((MK_PHASE_MASK >> (k)) & 1))
#define SEAM(k) do { if ((k) + 1 < hi) xcd_barrier(bar); } while (0)
    const int G = F.G, cid = (int)blockIdx.x;
    float* SS = (float*)(ws + WS_SS);
    bf16* XS = (bf16*)(ws + WS_XS);

    if (lo <= 0 && 0 < hi) { if (IN(0)) p0_prologue(F, args); SEAM(0); }
    if (lo <= 1 && 1 < hi) {
        if (IN(1)) {
            { pg8::Gemm g{XS, (const bf16*)(ws + WS_WIN0), MTOK, A_INP, DM}; pg8::StaticOrder S; S.init(MTOK, A_INP, G, cid);
              pg8::EpiWin0 E{SS, (const float*)(ws + WS_CS), (const float*)(ws + WS_SN), (bf16*)(ws + WS_Q0), (bf16*)(ws + WS_K0), (bf16*)(ws + WS_V0), (bf16*)(ws + WS_QI), (bf16*)(ws + WS_KI), (bf16*)(ws + WS_QM), (float*)(ws + WS_WI)};
              pg8::gemm_phase<pg8::EpiWin0, pg8::StaticOrder, true, true>(F.lds + RING_OFF, g, S, E); }
            { pg8::Gemm g{(const bf16*)(ws + WS_MB), (const bf16*)(ws + WS_WMKV0), MROWS, 512, DM}; pg8::ShiftOrder S; S.init(MROWS, 512, G, cid, 128);
              pg8::EpiScaled E{(bf16*)(ws + WS_MKV0), (const float*)(ws + WS_SSM), 512};
              pg8::gemm_phase<pg8::EpiScaled, pg8::ShiftOrder, true, true>(F.lds + RING_OFF, g, S, E); }
            { pg8::Gemm g{(const bf16*)(ws + WS_MB), (const bf16*)(ws + WS_WMKV1), MROWS, 512, DM}; pg8::ShiftOrder S; S.init(MROWS, 512, G, cid, 144);
              pg8::EpiScaled E{(bf16*)(ws + WS_MKV1), (const float*)(ws + WS_SSM), 512};
              pg8::gemm_phase<pg8::EpiScaled, pg8::ShiftOrder, true, true>(F.lds + RING_OFF, g, S, E); }
        }
        SEAM(1);
    }
    if (lo <= 2 && 2 < hi) { if (IN(2)) { indexer_phase(F, ws); } SEAM(2); }
    if (lo <= 3 && 3 < hi) { if (IN(3)) { if (MK_DSA) dsa_attn_phase(F, ws, (char*)lds + RING_OFF); else zero_cols(F, (bf16*)(ws + WS_O0), 1024, 768); mem_attn_phase(F, ws, 0, (char*)lds + RING_OFF); } SEAM(3); }
    if (lo <= 4 && 4 < hi) {
        if (IN(4)) { pg8::Gemm g{(const bf16*)(ws + WS_O0), (const bf16*)(ws + WS_WO0), MTOK, DM, DM}; pg8::StaticOrder S; S.init(MTOK, DM, G, cid);
            pg8::EpiResid<false> E{XS, nullptr, SS};
            pg8::gemm_phase<pg8::EpiResid<false>, pg8::StaticOrder, true, true>(F.lds + RING_OFF, g, S, E); }
        SEAM(4);
    }
    if (lo <= 5 && 5 < hi) {
        if (IN(5)) { pg8::Gemm g{XS, (const bf16*)(ws + WS_WGU0), MTOK, 2 * DFF, DM}; pg8::StaticOrder S; S.init(MTOK, 2 * DFF, G, cid);
            pg8::EpiGateUp E{(bf16*)(ws + WS_H), SS, DFF};
            pg8::gemm_phase<pg8::EpiGateUp, pg8::StaticOrder, true, true>(F.lds + RING_OFF, g, S, E); }
        SEAM(5);
    }
    if (lo <= 6 && 6 < hi) {
        if (IN(6)) { pg8::Gemm g{(const bf16*)(ws + WS_H), (const bf16*)(ws + WS_WD0), MTOK, DM, DFF}; pg8::StaticOrder S; S.init(MTOK, DM, G, cid);
            pg8::EpiResid<false> E{XS, nullptr, SS};
            pg8::gemm_phase<pg8::EpiResid<false>, pg8::StaticOrder, true, true>(F.lds + RING_OFF, g, S, E); }
        SEAM(6);
    }
    if (lo <= 7 && 7 < hi) {
        if (IN(7)) { pg8::Gemm g{XS, (const bf16*)(ws + WS_WIN1), MTOK, B_IN, DM}; pg8::StaticOrder S; S.init(MTOK, B_IN, G, cid);
            pg8::EpiWin1 E{SS, (const float*)(ws + WS_CS), (const float*)(ws + WS_SN), (bf16*)(ws + WS_P1)};
            pg8::gemm_phase<pg8::EpiWin1, pg8::StaticOrder, true, true>(F.lds + RING_OFF, g, S, E); }
        SEAM(7);
    }
    if (lo <= 8 && 8 < hi) { if (IN(8)) { if (MK_DIL) dil_attn_phase(F, ws, (char*)lds + RING_OFF); mem_attn_phase(F, ws, 1, (char*)lds + RING_OFF); } SEAM(8); }
    if (lo <= 9 && 9 < hi) { if (IN(9)) { if (MK_DIL) merge_phase(F, ws); else zero_cols(F, (bf16*)(ws + WS_O1), 512, 256); } SEAM(9); }
    if (lo <= 10 && 10 < hi) {
        if (IN(10)) { pg8::Gemm g{(const bf16*)(ws + WS_O1), (const bf16*)(ws + WS_WO1), MTOK, DM, 512}; pg8::StaticOrder S; S.init(MTOK, DM, G, cid);
            pg8::EpiResid<false> E{XS, nullptr, SS};
            pg8::gemm_phase<pg8::EpiResid<false>, pg8::StaticOrder, true, true>(F.lds + RING_OFF, g, S, E); }
        SEAM(10);
    }
    if (lo <= 11 && 11 < hi) {
        if (IN(11)) { pg8::Gemm g{XS, (const bf16*)(ws + WS_WGU1), MTOK, 2 * DFF, DM}; pg8::StaticOrder S; S.init(MTOK, 2 * DFF, G, cid);
            pg8::EpiGateUp E{(bf16*)(ws + WS_H), SS, DFF};
            pg8::gemm_phase<pg8::EpiGateUp, pg8::StaticOrder, true, true>(F.lds + RING_OFF, g, S, E); }
        SEAM(11);
    }
    if (lo <= 12 && 12 < hi) {
        if (IN(12)) { pg8::Gemm g{(const bf16*)(ws + WS_H), (const bf16*)(ws + WS_WD1), MTOK, DM, DFF}; pg8::StaticOrder S; S.init(MTOK, DM, G, cid);
            pg8::EpiResid<true> E{XS, args.out, SS};
            pg8::gemm_phase<pg8::EpiResid<true>, pg8::StaticOrder, true, true>(F.lds + RING_OFF, g, S, E); }
        SEAM(12);
    }
    if (lo <= 13 && 13 < hi) { if (IN(13)) final_norm_phase(F, args); }
#undef IN
#undef SEAM
}

extern "C" void kernel_launch(void* const* d_in, const int* in_sizes, int n_in, void* d_out, int out_size, void* d_ws, size_t ws_size, hipStream_t stream) {
    static int grid = 0;
    if (grid == 0) {
        if (n_in != 20 || out_size != MTOK * DM || ws_size < WS_END) { fprintf(stderr, "kernel_launch: unexpected shapes (n_in %d out %d ws %zu)\n", n_in, out_size, ws_size); grid = -1; return; }
        int dev = 0, cus = 0;
        if (hipGetDevice(&dev) != hipSuccess || hipDeviceGetAttribute(&cus, hipDeviceAttributeMultiprocessorCount, dev) != hipSuccess) { grid = -1; return; }
        if (hipFuncSetAttribute((const void*)mk_fwd, hipFuncAttributeMaxDynamicSharedMemorySize, LDS_BYTES) != hipSuccess) { fprintf(stderr, "kernel_launch: hipFuncSetAttribute failed\n"); grid = -1; return; }
        (void)hipGetLastError();
        grid = cus;
    }
    if (grid < 0) return;
    if (hipMemsetAsync((char*)d_ws + WS_CTL, 0, CTL_ZERO_BYTES, stream) != hipSuccess) return;
    Args a{};
    for (int i = 0; i < 20; ++i) a.in[i] = (const float*)d_in[i];
    a.out = (float*)d_out; a.ws = (unsigned char*)d_ws;
    if (MK_N_LAUNCHES == 1) { a.ph_lo = 0; a.ph_hi = N_PHASES; a.li = 0; hipLaunchKernelGGL(mk_fwd, dim3(grid), dim3(NWAVES * 64), LDS_BYTES, stream, a); }
    else for (int p = 0; p < N_PHASES; ++p) { if (!((MK_PHASE_MASK >> p) & 1)) continue; a.ph_lo = p; a.ph_hi = p + 1; a.li = p; hipLaunchKernelGGL(mk_fwd, dim3(grid), dim3(NWAVES * 64), LDS_BYTES, stream, a); }
}
```
